# Optimizing an MI355X kernel written in HIP

```python
import jax, jax.numpy as jnp
from jax import lax
import numpy as np

D_MODEL = 1024
BATCH = 8
SEQ = 4096
DEPTH = 1

D_MIX = D_MODEL
D_MLSTM = D_MIX // 2
D_POOL = D_MIX - D_MLSTM
N_MLSTM_HEADS = 4
HEAD_DIM = D_MLSTM // N_MLSTM_HEADS
POOL_WINDOWS = (2, 4, 8, 16)
N_POOL_GROUPS = len(POOL_WINDOWS)
POOL_GROUP_DIM = D_POOL // N_POOL_GROUPS
N_DIRS = 2
N_GATE_COLS = N_DIRS * 2 * N_MLSTM_HEADS
D_IN_PROJ = 4 * D_MLSTM + N_GATE_COLS + D_POOL
D_FF = 4 * D_MODEL
CHUNK = 128
EPS = 1e-6

kernel_name = "hybrid_mlstm_pool_adaln_encoder"


def _rmsnorm(x, g):
    xf = x.astype(jnp.float32)
    y = xf * lax.rsqrt(jnp.mean(xf * xf, axis=-1, keepdims=True) + EPS)
    return (y * g.astype(jnp.float32)).astype(x.dtype)


def _modulate(h, shift, scale):
    return h * (1 + scale[:, None, :]) + shift[:, None, :]


def _mlstm_scan(q, k, v, log_i, log_f):
    B, H, S, Dh = q.shape
    nc = S // CHUNK

    def to_chunks(a):
        a = a.reshape((B, H, nc, CHUNK) + a.shape[3:])
        return jnp.moveaxis(a, 2, 0)

    xs = (to_chunks(q), to_chunks(k), to_chunks(v), to_chunks(log_f), to_chunks(log_i))
    tril = jnp.tril(jnp.ones((CHUNK, CHUNK), dtype=bool))

    def step(carry, inp):
        C, n, m = carry
        q_c, k_c, v_c, lf, li = inp
        b = jnp.cumsum(lf, axis=-1)
        d = b[..., :, None] - b[..., None, :] + li[..., None, :]
        d = jnp.where(tril, d, -jnp.inf)
        inter = b + m[..., None]
        m_t = jnp.maximum(inter, jnp.max(d, axis=-1))
        w = jnp.exp(d - m_t[..., None])
        a = jnp.exp(inter - m_t)
        s = jnp.einsum('bhtd,bhsd->bhts', q_c, k_c) * w
        num = (jnp.einsum('bhts,bhse->bhte', s, v_c)
               + a[..., None] * jnp.einsum('bhtd,bhde->bhte', q_c, C))
        den = jnp.sum(s, axis=-1) + a * jnp.einsum('bhtd,bhd->bht', q_c, n)
        h = num / jnp.maximum(jnp.abs(den), jnp.exp(-m_t))[..., None]
        b_last = b[..., -1]
        g = b_last[..., None] - b + li
        m_new = jnp.maximum(b_last + m, jnp.max(g, axis=-1))
        decay = jnp.exp(b_last + m - m_new)
        wk = jnp.exp(g - m_new[..., None])
        C_new = decay[..., None, None] * C + jnp.einsum('bhs,bhsd,bhse->bhde', wk, k_c, v_c)
        n_new = decay[..., None] * n + jnp.einsum('bhs,bhsd->bhd', wk, k_c)
        return (C_new, n_new, m_new), h

    init = (jnp.zeros((B, H, Dh, Dh), jnp.float32),
            jnp.zeros((B, H, Dh), jnp.float32),
            jnp.zeros((B, H), jnp.float32))
    _, hs = lax.scan(step, init, xs)
    return jnp.moveaxis(hs, 0, 2).reshape(B, H, S, Dh)


def _multiscale_pool(u, w_pool, pool_scale):
    B, S, _ = u.shape
    uf = u.astype(jnp.float32).reshape(B, S, N_POOL_GROUPS, POOL_GROUP_DIM)
    prefix = jnp.concatenate([jnp.zeros_like(uf[:, :1]), jnp.cumsum(uf, axis=1)], axis=1)
    t = jnp.arange(S)
    means = []
    for gi, win in enumerate(POOL_WINDOWS):
        lo = jnp.clip(t - win // 2, 0, S)
        hi = jnp.clip(t + win // 2, 0, S)
        p = prefix[:, :, gi]
        cnt = (hi - lo).astype(jnp.float32)
        means.append((p[:, hi] - p[:, lo]) / cnt[None, :, None])
    pooled = jnp.stack(means, axis=2)
    mixed = (pooled - uf).astype(u.dtype)
    y = jnp.einsum('bsgc,gce->bsge', mixed, w_pool).reshape(B, S, D_POOL)
    return y * pool_scale


def _mixer(h, w_in, b_igate, b_fgate, g_head, w_pool, pool_scale, w_out):
    B, S, _ = h.shape
    H = N_MLSTM_HEADS
    proj = jnp.einsum('bsd,dp->bsp', h, w_in)
    cuts = [D_MLSTM, 2 * D_MLSTM, 3 * D_MLSTM, 4 * D_MLSTM, 4 * D_MLSTM + N_GATE_COLS]
    q, k, v, o, gates, u = jnp.split(proj, cuts, axis=-1)

    def heads(a):
        return a.reshape(B, S, H, HEAD_DIM).transpose(0, 2, 1, 3).astype(jnp.float32)

    qh = heads(q) * (HEAD_DIM ** -0.5)
    kh = heads(k)
    vh = heads(v)
    gates = gates.astype(jnp.float32).reshape(B, S, N_DIRS, 2, H).transpose(2, 3, 0, 4, 1)
    log_i = gates[:, 0] + b_igate.astype(jnp.float32)[:, None, :, None]
    log_f = jax.nn.log_sigmoid(gates[:, 1] + b_fgate.astype(jnp.float32)[:, None, :, None])

    def flip(a):
        return jnp.flip(a, axis=2)

    h_fwd = _mlstm_scan(qh, kh, vh, log_i[0], log_f[0])
    h_bwd = flip(_mlstm_scan(flip(qh), flip(kh), flip(vh), flip(log_i[1]), flip(log_f[1])))
    hm = h_fwd + h_bwd
    hm = hm * lax.rsqrt(jnp.mean(hm * hm, axis=-1, keepdims=True) + EPS)
    hm = hm * g_head.astype(jnp.float32).reshape(H, 1, HEAD_DIM)
    hm = hm.transpose(0, 2, 1, 3).reshape(B, S, D_MLSTM)
    y_a = (jax.nn.sigmoid(o.astype(jnp.float32)) * hm).astype(h.dtype)

    y_b = _multiscale_pool(u, w_pool, pool_scale)
    y = jnp.concatenate([y_a, y_b], axis=-1)
    return jnp.einsum('bsm,md->bsd', y, w_out)


def setup_inputs(seed: int = 0) -> dict:
    key = jax.random.key(seed)
    ks = jax.random.split(key, 17)
    f32 = jnp.float32
    H = N_MLSTM_HEADS

    def nrm(k, shape, scale):
        return jax.random.normal(k, shape, f32) * scale

    x = nrm(ks[0], (BATCH, SEQ, D_MODEL), 1.0)
    c = nrm(ks[1], (BATCH, D_MODEL), 1.0)
    w_ada = nrm(ks[2], (DEPTH, D_MODEL, 6 * D_MODEL), D_MODEL ** -0.5)
    b_ada = nrm(ks[3], (DEPTH, 6 * D_MODEL), 0.02)
    g_mix = 1.0 + nrm(ks[4], (DEPTH, D_MODEL), 0.05)
    w_in = nrm(ks[5], (DEPTH, D_MODEL, D_IN_PROJ), D_MODEL ** -0.5)
    b_igate = nrm(ks[6], (DEPTH, N_DIRS, H), 0.1)
    b_fgate = (jnp.broadcast_to(jnp.linspace(3.0, 6.0, H, dtype=f32), (DEPTH, N_DIRS, H))
               + nrm(ks[7], (DEPTH, N_DIRS, H), 0.1))
    g_head = 1.0 + nrm(ks[8], (DEPTH, D_MLSTM), 0.05)
    w_pool = nrm(ks[9], (DEPTH, N_POOL_GROUPS, POOL_GROUP_DIM, POOL_GROUP_DIM), POOL_GROUP_DIM ** -0.5)
    pool_scale = 1.0 + nrm(ks[10], (DEPTH, D_POOL), 0.1)
    w_out = nrm(ks[11], (DEPTH, D_MIX, D_MODEL), D_MIX ** -0.5)
    g_ffn = 1.0 + nrm(ks[12], (DEPTH, D_MODEL), 0.05)
    w_ff1 = nrm(ks[13], (DEPTH, D_MODEL, D_FF), D_MODEL ** -0.5)
    w_ff2 = nrm(ks[14], (DEPTH, D_FF, D_MODEL), D_FF ** -0.5)
    g_final = 1.0 + nrm(ks[15], (D_MODEL,), 0.05)
    return {"x": x, "c": c, "w_ada": w_ada, "b_ada": b_ada, "g_mix": g_mix, "w_in": w_in,
            "b_igate": b_igate, "b_fgate": b_fgate, "g_head": g_head, "w_pool": w_pool,
            "pool_scale": pool_scale, "w_out": w_out, "g_ffn": g_ffn, "w_ff1": w_ff1,
            "w_ff2": w_ff2, "g_final": g_final}


def reference(x, c, w_ada, b_ada, g_mix, w_in, b_igate, b_fgate, g_head, w_pool,
              pool_scale, w_out, g_ffn, w_ff1, w_ff2, g_final):
    c_act = jax.nn.silu(c)
    for l in range(DEPTH):
        mod = c_act @ w_ada[l] + b_ada[l]
        sh1, sc1, gt1, sh2, sc2, gt2 = jnp.split(mod, 6, axis=-1)
        h = _modulate(_rmsnorm(x, g_mix[l]), sh1, sc1)
        x = x + gt1[:, None, :] * _mixer(h, w_in[l], b_igate[l], b_fgate[l], g_head[l],
                                         w_pool[l], pool_scale[l], w_out[l])
        h = _modulate(_rmsnorm(x, g_ffn[l]), sh2, sc2)
        a = jnp.square(jax.nn.relu(jnp.einsum('bsd,df->bsf', h, w_ff1[l])))
        x = x + gt2[:, None, :] * jnp.einsum('bsf,fd->bsd', a, w_ff2[l])
    return _rmsnorm(x, g_final)
```

```cpp
#include <hip/hip_runtime.h>
#include <cstdio>
#include <cstdint>
namespace pg8 {
#define PG8_LAS __attribute__((address_space(3)))
typedef unsigned short bf16_t;
typedef short bf16x8 __attribute__((ext_vector_type(8)));
typedef float f32x4 __attribute__((ext_vector_type(4)));
typedef unsigned u32x4 __attribute__((ext_vector_type(4)));
constexpr int BM = 256, BK = 64, HALF = 128, HTB = HALF * BK * 2  , STAGE_BYTES = 8 * HTB, NXCD = 8, WGM = 8;

__host__ __device__ __forceinline__ int lds_byte(int r, int c) { const int st = (r >> 4) * 2 + (c >> 5), rr = r & 15, cc = c & 31, ob = rr * 64 + cc * 2; return st * 1024 + (ob ^ (((ob >> 9) & 1) << 5)); }
__host__ __device__ __forceinline__ void stage_rc(int b, int& R, int& C) { const int st = b / 1024, sb = b % 1024, swz = sb ^ (((sb >> 9) & 1) << 5); R = (st >> 1) * 16 + swz / 64; C = (st & 1) * 32 + (swz % 64) / 2; }
__host__ __device__ __forceinline__ int perm32(int rho) { const int n = rho >> 4, i = rho & 15; return 8 * (i >> 2) + 4 * n + (i & 3); }

struct Unit { int pm, pn; };
struct Gemm { const bf16_t* A; const bf16_t* Bt; int M, N, K; };

struct StaticOrder {
    int nM, nN, nwg, G, c;
    __host__ __device__ void init(int M, int N, int G_, int c_) { nM = M / BM; nN = N / BM; nwg = nM * nN; G = G_; c = c_; }
    __host__ __device__ bool next(int i, Unit& u) const {
        const long L = (long)i * G + c; if (L >= nwg) return false;
        int wgid = (int)L; { const int q = nwg / NXCD, r = nwg % NXCD, xcd = wgid % NXCD, off = wgid / NXCD; wgid = (xcd < r ? xcd * (q + 1) : r * (q + 1) + (xcd - r) * q) + off; }
        const int nig = WGM * nN, gid = wgid / nig, fm = gid * WGM, gsz = (nM - fm) < WGM ? (nM - fm) : WGM;
        u.pm = fm + ((wgid % nig) % gsz); u.pn = (wgid % nig) / gsz; return true;
    }
    __device__ __forceinline__ void a_ready(const Unit&) const {}
    __device__ __forceinline__ void done(const Unit&) const {}
};


__device__ __forceinline__ unsigned cvt_pk_bf16(float lo, float hi) { unsigned r; asm volatile("v_cvt_pk_bf16_f32 %0, %1, %2" : "=v"(r) : "v"(lo), "v"(hi)); return r; }
__device__ __forceinline__ float sigmoidf_fast(float x) { return __builtin_amdgcn_rcpf(1.0f + __builtin_amdgcn_exp2f(-1.4426950408889634f * x)); }

struct EpiProj {
    static constexpr bool PERM = true, AFTER_DRAIN = false;
    bf16_t* O; size_t split_stride;
    __device__ __forceinline__ void operator()(const f32x4 (&acc)[2][2][4][2], const Unit& u, int wr, int wc, int fr, int fq) const {
        const int row0 = u.pm * BM + wr * 64 + fr; const int t = u.pn >> 1;
        bf16_t* base = O + (size_t)t * split_stride;
        const int col0 = (u.pn & 1) * 256 + wc * 32 + 8 * fq;
        const float sc = (t == 0) ? 0.08838834764831845f : 1.0f;
#pragma unroll
        for (int ai = 0; ai < 2; ++ai)
#pragma unroll
            for (int m = 0; m < 4; ++m) { bf16_t* rowp = base + (size_t)(row0 + ai * HALF + m * 16) * 512 + col0;
#pragma unroll
                for (int bj = 0; bj < 2; ++bj) { f32x4 v0 = acc[ai][bj][m][0] * sc, v1 = acc[ai][bj][m][1] * sc;
                    if (t == 3) {
#pragma unroll
                        for (int q = 0; q < 4; ++q) { v0[q] = sigmoidf_fast(v0[q]); v1[q] = sigmoidf_fast(v1[q]); } }
                    u32x4 w; w.x = cvt_pk_bf16(v0[0], v0[1]); w.y = cvt_pk_bf16(v0[2], v0[3]); w.z = cvt_pk_bf16(v1[0], v1[1]); w.w = cvt_pk_bf16(v1[2], v1[3]);
                    *(u32x4*)(rowp + bj * HALF) = w; } }
    }
};
struct EpiRelu2 {
    static constexpr bool PERM = true, AFTER_DRAIN = false;
    bf16_t* O; int ldc;
    __device__ __forceinline__ void operator()(const f32x4 (&acc)[2][2][4][2], const Unit& u, int wr, int wc, int fr, int fq) const {
        const int row0 = u.pm * BM + wr * 64 + fr; const int col0 = u.pn * BM + wc * 32 + 8 * fq;
#pragma unroll
        for (int ai = 0; ai < 2; ++ai)
#pragma unroll
            for (int m = 0; m < 4; ++m) { bf16_t* rowp = O + (size_t)(row0 + ai * HALF + m * 16) * ldc + col0;
#pragma unroll
                for (int bj = 0; bj < 2; ++bj) { f32x4 v0 = acc[ai][bj][m][0], v1 = acc[ai][bj][m][1];
#pragma unroll
                    for (int q = 0; q < 4; ++q) { const float a = fmaxf(v0[q], 0.f), b = fmaxf(v1[q], 0.f); v0[q] = a * a; v1[q] = b * b; }
                    u32x4 w; w.x = cvt_pk_bf16(v0[0], v0[1]); w.y = cvt_pk_bf16(v0[2], v0[3]); w.z = cvt_pk_bf16(v1[0], v1[1]); w.w = cvt_pk_bf16(v1[2], v1[3]);
                    *(u32x4*)(rowp + bj * HALF) = w; } }
    }
};
struct EpiRes {
    static constexpr bool PERM = false, AFTER_DRAIN = false;
    const float* base; float* out; const float* gate;
    __device__ __forceinline__ void operator()(const f32x4 (&acc)[2][2][4][2], const Unit& u, int wr, int wc, int fr, int fq) const {
        const int row0 = u.pm * BM + wr * 64 + fr, col0 = u.pn * BM + wc * 32 + 4 * fq;
        const float* gv = gate + (size_t)(u.pm >> 4) * 6144 + col0;
        f32x4 g[2][2];
#pragma unroll
        for (int bj = 0; bj < 2; ++bj)
#pragma unroll
            for (int n = 0; n < 2; ++n) g[bj][n] = *(const f32x4*)(gv + bj * HALF + n * 16);
#pragma unroll
        for (int ai = 0; ai < 2; ++ai)
#pragma unroll
            for (int m = 0; m < 4; ++m) { const size_t off = (size_t)(row0 + ai * HALF + m * 16) * 1024 + col0;
#pragma unroll
                for (int bj = 0; bj < 2; ++bj)
#pragma unroll
                    for (int n = 0; n < 2; ++n) { const f32x4 bs = *(const f32x4*)(base + off + bj * HALF + n * 16);
                        *(f32x4*)(out + off + bj * HALF + n * 16) = bs + g[bj][n] * acc[ai][bj][m][n]; }
                if (m & 1) asm volatile("" ::: "memory"); }
    }
};

template <class Epi, class Sched, bool ALIGN_EPI = false, bool SP2 = false>
__device__ __forceinline__ void gemm_phase(PG8_LAS unsigned char* lds, const Gemm g, const Sched& S, const Epi& E) {
    const int tid = threadIdx.x, wid = __builtin_amdgcn_readfirstlane(tid >> 6), lane = tid & 63, wr = wid >> 2, wc = wid & 3, fr = lane & 15, fq = lane >> 4;
    const int K = g.K, nt = K / BK;
    unsigned voffA[2], voffB[2];
#pragma unroll
    for (int i = 0; i < 2; ++i) { int R, C; stage_rc(tid * 16 + i * 8192, R, C); const int Rb = Epi::PERM ? ((R & ~31) + perm32(R & 31)) : R;
        voffA[i] = (unsigned)(R * K + C) * 2u; voffB[i] = (unsigned)(Rb * K + C) * 2u; }
    const size_t kstep = (size_t)(BK * 2);
    const size_t hstep = (size_t)HALF * K * 2;
    const size_t tstep = 2 * hstep;
    const unsigned ldsw = (unsigned)wid * 1024u;
    const int aoff = lds_byte(wr * 64 + fr, fq * 8), boff = lds_byte(wc * 32 + fr, fq * 8);
#define PG8_SA(b, h) (((b) * 2 + (h)) * HTB)
#define PG8_SB(b, h) ((4 + (b) * 2 + (h)) * HTB)
#define PG8_STAGE(bufoff, gbase, voff) do { _Pragma("unroll") for (int _i = 0; _i < 2; ++_i) \
        __builtin_amdgcn_global_load_lds((const unsigned*)((const char*)(gbase) + (voff)[_i]), (PG8_LAS unsigned*)(lds + (bufoff) + ldsw + _i * 8192), 16, 0, 0); } while (0)
#define PG8_LDA(dst, b, h) do { _Pragma("unroll") for (int m = 0; m < 4; ++m) _Pragma("unroll") for (int k = 0; k < 2; ++k) dst[m][k] = *(const PG8_LAS bf16x8*)(lds + PG8_SA(b, h) + aoff + m * 2048 + k * 1024); } while (0)
#define PG8_LDB(dst, b, h) do { _Pragma("unroll") for (int n = 0; n < 2; ++n) _Pragma("unroll") for (int k = 0; k < 2; ++k) dst[n][k] = *(const PG8_LAS bf16x8*)(lds + PG8_SB(b, h) + boff + n * 2048 + k * 1024); } while (0)
#define PG8_MMA(ai, bj, At, Bt) do { __builtin_amdgcn_s_setprio(1); _Pragma("unroll") for (int m = 0; m < 4; ++m) _Pragma("unroll") for (int n = 0; n < 2; ++n) _Pragma("unroll") for (int k = 0; k < 2; ++k) \
        acc[ai][bj][m][n] = __builtin_amdgcn_mfma_f32_16x16x32_bf16(Bt[n][k], At[m][k], acc[ai][bj][m][n], 0, 0, 0); __builtin_amdgcn_s_setprio(0); } while (0)
#define PG8_WAIT_V(n) asm volatile("s_waitcnt vmcnt(" #n ")" ::: "memory")
#define PG8_WAIT_L(n) asm volatile("s_waitcnt lgkmcnt(" #n ")" ::: "memory")
#define PG8_BAR __builtin_amdgcn_s_barrier()
#define PG8_SCHED __builtin_amdgcn_sched_barrier(0)
    Unit cur, nxt; int ui = 0;
    if (!S.next(0, cur)) return;
    f32x4 acc[2][2][4][2];
#pragma unroll
    for (int a = 0; a < 2; ++a)
#pragma unroll
        for (int b = 0; b < 2; ++b)
#pragma unroll
            for (int m = 0; m < 4; ++m)
#pragma unroll
                for (int n = 0; n < 2; ++n) acc[a][b][m][n] = (f32x4){0.f, 0.f, 0.f, 0.f};
    bf16x8 At[4][2], B0[2][2], B1[2][2];
    const char* cA = (const char*)g.A + (size_t)cur.pm * tstep; const char* cB = (const char*)g.Bt + (size_t)cur.pn * tstep;
    S.a_ready(cur);
    if constexpr (SP2) {
        PG8_STAGE(PG8_SB(0, 0), cB, voffB); PG8_STAGE(PG8_SB(0, 1), cB + hstep, voffB); PG8_STAGE(PG8_SA(0, 0), cA, voffA); PG8_STAGE(PG8_SA(0, 1), cA + hstep, voffA);
        if (wr == 1) PG8_BAR;
        PG8_WAIT_V(2); PG8_BAR;
        PG8_STAGE(PG8_SB(1, 0), cB + kstep, voffB); PG8_STAGE(PG8_SA(1, 0), cA + kstep, voffA); PG8_STAGE(PG8_SB(1, 1), cB + hstep + kstep, voffB);
        PG8_WAIT_V(6); PG8_BAR;
    } else {
        PG8_STAGE(PG8_SB(0, 0), cB, voffB); PG8_STAGE(PG8_SA(0, 0), cA, voffA); PG8_STAGE(PG8_SB(0, 1), cB + hstep, voffB); PG8_STAGE(PG8_SA(0, 1), cA + hstep, voffA);
        if (wr == 1) PG8_BAR;
        PG8_WAIT_V(4); PG8_BAR;
        PG8_STAGE(PG8_SB(1, 0), cB + kstep, voffB); PG8_STAGE(PG8_SA(1, 0), cA + kstep, voffA); PG8_STAGE(PG8_SB(1, 1), cB + hstep + kstep, voffB);
        PG8_WAIT_V(6); PG8_BAR;
    }
    for (;;) {
        const bool has_next = S.next(ui + 1, nxt);
        const char* nA = has_next ? (const char*)g.A + (size_t)nxt.pm * tstep : cA; const char* nB = has_next ? (const char*)g.Bt + (size_t)nxt.pn * tstep : cB;
        for (int t = 0; t < nt; t += 2) {
            const bool last = (t == nt - 2);
            const char* a1 = cA + (size_t)(t + 1) * kstep;
            const char* a2 = last ? nA : cA + (size_t)(t + 2) * kstep; const char* b2 = last ? nB : cB + (size_t)(t + 2) * kstep;
            const char* a3 = a2 + kstep; const char* b3 = b2 + kstep;
            if (last && has_next) S.a_ready(nxt);
            if constexpr (SP2) {
            PG8_LDB(B0, 0, 0); PG8_LDB(B1, 0, 1); PG8_SCHED; PG8_LDA(At, 0, 0); PG8_STAGE(PG8_SA(1, 1), a1 + hstep, voffA);
            PG8_WAIT_V(8); PG8_WAIT_L(0); PG8_BAR; PG8_MMA(0, 0, At, B0); PG8_MMA(0, 1, At, B1); PG8_BAR; PG8_SCHED;
            PG8_LDA(At, 0, 1); PG8_STAGE(PG8_SB(0, 0), b2, voffB); PG8_STAGE(PG8_SB(0, 1), b2 + hstep, voffB); PG8_STAGE(PG8_SA(0, 0), a2, voffA);
            PG8_WAIT_V(8); PG8_WAIT_L(0); PG8_BAR; PG8_MMA(1, 0, At, B0); PG8_MMA(1, 1, At, B1); PG8_BAR; PG8_SCHED;
            PG8_LDB(B0, 1, 0); PG8_LDB(B1, 1, 1); PG8_SCHED; PG8_LDA(At, 1, 0); PG8_STAGE(PG8_SA(0, 1), a2 + hstep, voffA);
            PG8_WAIT_V(8); PG8_WAIT_L(0); PG8_BAR; PG8_MMA(0, 0, At, B0); PG8_MMA(0, 1, At, B1); PG8_BAR; PG8_SCHED;
            PG8_LDA(At, 1, 1); PG8_STAGE(PG8_SB(1, 0), b3, voffB); PG8_STAGE(PG8_SB(1, 1), b3 + hstep, voffB); PG8_STAGE(PG8_SA(1, 0), a3, voffA);
            PG8_WAIT_V(8); PG8_WAIT_L(0); PG8_BAR; PG8_MMA(1, 0, At, B0); PG8_MMA(1, 1, At, B1); PG8_BAR; PG8_SCHED;
            } else {
            PG8_LDB(B0, 0, 0); PG8_SCHED; PG8_LDA(At, 0, 0); PG8_STAGE(PG8_SA(1, 1), a1 + hstep, voffA);
            PG8_WAIT_L(8); PG8_BAR; PG8_WAIT_L(0); PG8_MMA(0, 0, At, B0); PG8_BAR; PG8_SCHED;
            PG8_LDB(B1, 0, 1); PG8_STAGE(PG8_SB(0, 0), b2, voffB);
            PG8_BAR; PG8_WAIT_L(0); PG8_MMA(0, 1, At, B1); PG8_BAR;
            PG8_LDA(At, 0, 1); PG8_STAGE(PG8_SA(0, 0), a2, voffA);
            PG8_BAR; PG8_WAIT_L(0); PG8_MMA(1, 0, At, B0); PG8_BAR; PG8_SCHED;
            PG8_STAGE(PG8_SB(0, 1), b2 + hstep, voffB);
            PG8_WAIT_V(6); PG8_BAR; PG8_MMA(1, 1, At, B1); PG8_BAR;
            PG8_LDB(B0, 1, 0); PG8_SCHED; PG8_LDA(At, 1, 0); PG8_STAGE(PG8_SA(0, 1), a2 + hstep, voffA);
            PG8_WAIT_L(8); PG8_BAR; PG8_WAIT_L(0); PG8_MMA(0, 0, At, B0); PG8_BAR; PG8_SCHED;
            PG8_LDB(B1, 1, 1); PG8_STAGE(PG8_SB(1, 0), b3, voffB);
            PG8_BAR; PG8_WAIT_L(0); PG8_MMA(0, 1, At, B1); PG8_BAR;
            PG8_LDA(At, 1, 1); PG8_STAGE(PG8_SA(1, 0), a3, voffA);
            PG8_BAR; PG8_WAIT_L(0); PG8_MMA(1, 0, At, B0); PG8_BAR; PG8_SCHED;
            PG8_STAGE(PG8_SB(1, 1), b3 + hstep, voffB);
            PG8_WAIT_V(6); PG8_BAR; PG8_MMA(1, 1, At, B1); PG8_BAR;
            }
        }
        if constexpr (ALIGN_EPI) { if (wr == 0) PG8_BAR; }
        if constexpr (!Epi::AFTER_DRAIN) { E(acc, cur, wr, wc, fr, fq); S.done(cur); }
        if (!has_next) break;
#pragma unroll
        for (int a = 0; a < 2; ++a)
#pragma unroll
            for (int b = 0; b < 2; ++b)
#pragma unroll
                for (int m = 0; m < 4; ++m)
#pragma unroll
                    for (int n = 0; n < 2; ++n) acc[a][b][m][n] = (f32x4){0.f, 0.f, 0.f, 0.f};
        cur = nxt; cA = nA; cB = nB; ++ui;
        if constexpr (ALIGN_EPI) { if (wr == 1) PG8_BAR; }
    }
    PG8_WAIT_V(0);
    if constexpr (!ALIGN_EPI) { if (wr == 0) PG8_BAR; }
    PG8_BAR;
    if constexpr (Epi::AFTER_DRAIN) { E.fused(acc, cur, wr, wc, fr, fq, lds, wid, lane); S.done(cur); }
#undef PG8_SA
#undef PG8_SB
#undef PG8_STAGE
#undef PG8_LDA
#undef PG8_LDB
#undef PG8_MMA
#undef PG8_WAIT_V
#undef PG8_WAIT_L
#undef PG8_BAR
#undef PG8_SCHED
}
}
#ifndef PG8_SP2
#define PG8_SP2 true
#endif
#ifndef PG8_ALIGN
#define PG8_ALIGN true
#endif
constexpr int NWAVES = 8;
#ifndef MK_N_LAUNCHES
#define MK_N_LAUNCHES 1
#endif
constexpr int PER_PHASE = 10;
constexpr int N_LAUNCHES = MK_N_LAUNCHES;

constexpr int BATCH = 8, SEQ = 4096, D = 1024, M = BATCH * SEQ, DML = 512, NH = 4, DH = 128, DPOOL = 512, DIN = 2576, FF = 4096, CHUNK = 128, NCHUNK = SEQ / CHUNK;
constexpr int NPROJ = 2560;
constexpr float EPS = 1e-6f;
constexpr float LOG2E = 1.4426950408889634f;

constexpr size_t MiB = 1u << 20;
constexpr size_t WS_CTL = 0, CTL_ZERO_BYTES = 1 * MiB;
constexpr size_t WS_MOD = 1 * MiB;
constexpr size_t WS_WIN = 2 * MiB, WS_WOUT = 7 * MiB, WS_W1 = 9 * MiB, WS_W2 = 17 * MiB;
constexpr size_t WS_GT = 26 * MiB;
constexpr size_t WS_H = 32 * MiB;
constexpr size_t WS_Q = 96 * MiB, WS_K = 128 * MiB, WS_V = 160 * MiB, WS_O = 192 * MiB, WS_U = 224 * MiB;
constexpr size_t WS_HF = 256 * MiB, WS_HB = 320 * MiB;
constexpr size_t WS_A = 96 * MiB;
constexpr size_t WS_END = 384 * MiB;
constexpr int CW_TMO = 0, CW_CODE = 1;
constexpr int CW_BAR = 4096;

constexpr int RING_OFF = 0, RING_BYTES = 131072;
constexpr int LDSCTL_OFF = RING_BYTES, MISC_OFF = LDSCTL_OFF + 320;
constexpr int LDS_BYTES = 147456;
static_assert(MISC_OFF + 128 <= LDS_BYTES, "LDS map");

#define GAS __attribute__((address_space(1)))
#define LAS __attribute__((address_space(3)))
typedef unsigned short bf16;
typedef unsigned v4u __attribute__((ext_vector_type(4)));
typedef float f32x4 __attribute__((ext_vector_type(4)));
typedef short bf16x8 __attribute__((ext_vector_type(8)));
typedef GAS unsigned gu32;
typedef GAS unsigned long long gu64;
#define RLX_AGENT __ATOMIC_RELAXED, __HIP_MEMORY_SCOPE_AGENT
#define LDS_WAIT() asm volatile("s_waitcnt lgkmcnt(0)" ::: "memory")
#define VM_WAIT() asm volatile("s_waitcnt vmcnt(0)" ::: "memory")
__device__ __forceinline__ unsigned long long rt() { return __builtin_amdgcn_s_memrealtime(); }
__device__ __forceinline__ unsigned f2bf(float f) { unsigned u = __builtin_bit_cast(unsigned, f); return (u + 0x7fffu + ((u >> 16) & 1u)) >> 16; }
__device__ __forceinline__ unsigned pk2(float lo, float hi) { return f2bf(lo) | (f2bf(hi) << 16); }

#define XB_TMO      128
#define XB_XCNT(j)  (256  + 64 * (j))
#define XB_XSUB(j)  (1280 + 64 * (j))
#define XB_XGEN(j)  (2304 + 64 * (j))
#define XB_TOP      3328
#define XB_TOPGEN   3392
#define XCD_BAR_WORDS 3456
#define XB_SPIN_CAP (1u << 18)

__device__ __forceinline__ unsigned xb_ld(unsigned* p)              { return __hip_atomic_load(p, __ATOMIC_RELAXED, __HIP_MEMORY_SCOPE_AGENT); }
__device__ __forceinline__ unsigned xb_add(unsigned* p, unsigned v) { return __hip_atomic_fetch_add(p, v, __ATOMIC_RELAXED, __HIP_MEMORY_SCOPE_AGENT); }
__device__ __forceinline__ unsigned xb_xcc_id() { return (unsigned)__builtin_amdgcn_s_getreg((3 << 11) | 20) & 0xFu; }
#define XB_SPIN(cond, bar) do { unsigned _sp = 0; while (cond) { __builtin_amdgcn_s_sleep(1); \
    if ((++_sp & 255u) == 0u) { if (xb_ld(&(bar)[XB_TMO])) break; if (_sp > XB_SPIN_CAP) { atomicAdd(&(bar)[XB_TMO], 1u); break; } } } } while (0)

struct XcdBarrier {
    unsigned* bar; unsigned x;
    volatile LAS unsigned* st;
};

__device__ __forceinline__ XcdBarrier xcd_barrier_post(unsigned* bar, volatile LAS unsigned* st) {
    XcdBarrier b; b.bar = bar; b.x = xb_xcc_id(); b.st = st;
    if (threadIdx.x == 0) (void)xb_add(&bar[XB_XCNT(b.x)], 1u);
    return b;
}
__device__ __forceinline__ void xcd_barrier_complete(unsigned* bar, unsigned x, unsigned& nloc, unsigned& nx) {
    const unsigned G = gridDim.x * gridDim.y * gridDim.z;
    unsigned sum, cnt, mine, sp = 0u;
    for (;;) {
        sum = 0u; cnt = 0u; mine = 0u;
#pragma unroll
        for (unsigned j = 0; j < 16; ++j) { const unsigned c = xb_ld(&bar[XB_XCNT(j)]); sum += c; cnt += (c > 0u) ? 1u : 0u; mine = (j == x) ? c : mine; }
        if (sum == G) break;
        __builtin_amdgcn_s_sleep(1);
        if ((++sp & 255u) == 0u) { if (xb_ld(&bar[XB_TMO])) break; if (sp > XB_SPIN_CAP) { atomicAdd(&bar[XB_TMO], 1u); break; } }
    }
    nloc = mine > 0u ? mine : 1u; nx = cnt > 0u ? cnt : 1u;
}

__device__ __forceinline__ void xcd_barrier(const XcdBarrier& b) {
    asm volatile("s_waitcnt vmcnt(0)" ::: "memory");
    __syncthreads();
    if (threadIdx.x == 0) {
        unsigned* bar = b.bar;
        __builtin_amdgcn_s_waitcnt(0);
        unsigned nloc = b.st[0], nx = b.st[1];
        if (nloc == 0u) { xcd_barrier_complete(bar, b.x, nloc, nx); b.st[0] = nloc; b.st[1] = nx; }
        const unsigned old = xb_add(&bar[XB_XSUB(b.x)], 1u);
        const unsigned gen = old / nloc;
        if (old + 1u == (gen + 1u) * nloc) {
            __builtin_amdgcn_fence(__ATOMIC_RELEASE, "agent");
            asm volatile("s_waitcnt vmcnt(0)" ::: "memory");
            const unsigned og = xb_add(&bar[XB_TOP], 1u);
            const unsigned tg = og / nx;
            if (og + 1u == (tg + 1u) * nx) xb_add(&bar[XB_TOPGEN], 1u);
            else XB_SPIN(xb_ld(&bar[XB_TOPGEN]) == tg, bar);
            __builtin_amdgcn_fence(__ATOMIC_ACQUIRE, "agent");
            xb_add(&bar[XB_XGEN(b.x)], 1u);
            asm volatile("s_waitcnt vmcnt(0)" ::: "memory");
        } else {
            XB_SPIN(xb_ld(&bar[XB_XGEN(b.x)]) == gen, bar);
            __builtin_amdgcn_fence(__ATOMIC_ACQUIRE, "agent");
            asm volatile("s_waitcnt vmcnt(0)" ::: "memory");
        }
    }
    __syncthreads();
}

struct Frame {
    LAS unsigned char* lds;
    volatile LAS unsigned* MISC;
    gu32* ctl;
    int tid, lane, wave;
    int vcu, G;
    const float *x, *c, *w_ada, *b_ada, *g_mix, *w_in, *b_ig, *b_fg, *g_head, *w_pool, *pool_scale, *w_out, *g_ffn, *w_ff1, *w_ff2, *g_final;
    float* out;
    float* mod; float* GT; float *HF, *HB;
    bf16 *WIN, *WOUT, *W1, *W2, *HBUF, *QB, *KB, *VB, *OB, *UB, *AB;
};

__device__ __forceinline__ float wave_sum(float v) {
#pragma unroll
    for (int o = 1; o < 64; o <<= 1) v += __shfl_xor(v, o);
    return v;
}
__device__ __forceinline__ float bf2f(unsigned short h) { return __builtin_bit_cast(float, (unsigned)h << 16); }
__device__ __forceinline__ float bflo(unsigned w) { return __builtin_bit_cast(float, w << 16); }
__device__ __forceinline__ float bfhi(unsigned w) { return __builtin_bit_cast(float, w & 0xffff0000u); }

__device__ __forceinline__ void p0_transpose_item(const float* W, int ldw, int c0, bf16* WT, int ldt, int r0, int k0, LAS float* scr, int lane) {
#pragma unroll 8
    for (int i = 0; i < 32; ++i) { const int kk = 2 * i + (lane >> 5); scr[kk * 33 + (lane & 31)] = W[(size_t)(k0 + kk) * ldw + c0 + (lane & 31)]; }
    LDS_WAIT(); asm volatile("" ::: "memory");
    const int c = lane & 7;
#pragma unroll
    for (int j = 0; j < 4; ++j) { const int n = (lane >> 3) + 8 * j; const LAS float* s = scr + (8 * c) * 33 + n;
        v4u o; o.x = pk2(s[0 * 33], s[1 * 33]); o.y = pk2(s[2 * 33], s[3 * 33]); o.z = pk2(s[4 * 33], s[5 * 33]); o.w = pk2(s[6 * 33], s[7 * 33]);
        *(GAS v4u*)(WT + (size_t)(r0 + n) * ldt + k0 + 8 * c) = o; }
    LDS_WAIT(); asm volatile("" ::: "memory");
}

__device__ __forceinline__ void p0_prologue(Frame& F) {
    const int lane = F.lane, wave = F.wave, tid = F.tid;
    if (F.vcu < 192) {
        LAS float* cact = (LAS float*)(F.lds + RING_OFF);
        LAS float* red = (LAS float*)(F.lds + RING_OFF + 32768);
        for (int i = tid; i < BATCH * D; i += NWAVES * 64) { const float v = F.c[i]; cact[i] = v * pg8::sigmoidf_fast(v); }
        __syncthreads();
        const int it = F.vcu, cl = lane & 7, kr = lane >> 3;
        f32x4 acc[8];
#pragma unroll
        for (int b = 0; b < 8; ++b) acc[b] = (f32x4){0.f, 0.f, 0.f, 0.f};
#pragma unroll 4
        for (int i = 0; i < 16; ++i) { const int k = 128 * wave + 8 * i + kr;
            const f32x4 wv = *(const GAS f32x4*)(F.w_ada + (size_t)k * 6144 + 32 * it + 4 * cl);
#pragma unroll
            for (int b = 0; b < 8; ++b) acc[b] += cact[b * D + k] * wv; }
#pragma unroll
        for (int b = 0; b < 8; ++b)
#pragma unroll
            for (int q = 0; q < 4; ++q) { float v = acc[b][q]; v += __shfl_xor(v, 8); v += __shfl_xor(v, 16); v += __shfl_xor(v, 32); acc[b][q] = v; }
        if (kr == 0) {
#pragma unroll
            for (int b = 0; b < 8; ++b) *(LAS f32x4*)(red + (wave * 8 + b) * 32 + 4 * cl) = acc[b]; }
        __syncthreads();
        if (tid < 256) { const int b = tid >> 5, col = tid & 31; float s = 0.f;
#pragma unroll
            for (int w = 0; w < 8; ++w) s += red[(w * 8 + b) * 32 + col];
            F.mod[b * 6144 + 32 * it + col] = s + F.b_ada[32 * it + col]; }
        __syncthreads();
    }
    LAS float* scr = (LAS float*)(F.lds + RING_OFF + wave * 16384);
    const int gw = F.vcu * NWAVES + wave, NGW = F.G * NWAVES;
    constexpr int I_A = 16 * 64, I_B = 16 * 16, I_C = 8 * 32, I_D = 16 * 128, I_E = 64 * 32;
    constexpr int NITEMS = I_A + I_B + I_C + I_D + I_E;
    for (int it = gw; it < NITEMS; it += NGW) {
        int r = it;
        if (r < I_A) { const int kb = r / 64, nb = r % 64; p0_transpose_item(F.w_in, DIN, 32 * nb, F.WIN, D, 32 * nb, 64 * kb, scr, lane); continue; } r -= I_A;
        if (r < I_B) { const int kb = r / 16, nb = r % 16; p0_transpose_item(F.w_in, DIN, 2064 + 32 * nb, F.WIN, D, 2048 + 32 * nb, 64 * kb, scr, lane); continue; } r -= I_B;
        if (r < I_C) { const int kb = r / 32, nb = r % 32; p0_transpose_item(F.w_out, D, 32 * nb, F.WOUT, D, 32 * nb, 64 * kb, scr, lane); continue; } r -= I_C;
        if (r < I_D) { const int kb = r / 128, nb = r % 128; p0_transpose_item(F.w_ff1, FF, 32 * nb, F.W1, D, 32 * nb, 64 * kb, scr, lane); continue; } r -= I_D;
        { const int kb = r / 32, nb = r % 32; p0_transpose_item(F.w_ff2, D, 32 * nb, F.W2, FF, 32 * nb, 64 * kb, scr, lane); }
    }
    for (int it = gw; it < 512; it += NGW) {
        const int g = it >> 7, nblk = (it >> 3) & 15, cblk = it & 7, n = 64 * nblk + lane, c0 = 16 * cblk;
        float acc[16];
#pragma unroll
        for (int cc = 0; cc < 16; ++cc) acc[cc] = 0.f;
        for (int e = 0; e < 128; ++e) {
            const float wo = F.w_out[(size_t)(512 + g * 128 + e) * D + n] * F.pool_scale[g * 128 + e];
#pragma unroll
            for (int cc = 0; cc < 16; ++cc) acc[cc] += F.w_pool[(size_t)(g * 128 + c0 + cc) * 128 + e] * wo;
        }
        v4u o0, o1;
        o0.x = pk2(acc[0], acc[1]); o0.y = pk2(acc[2], acc[3]); o0.z = pk2(acc[4], acc[5]); o0.w = pk2(acc[6], acc[7]);
        o1.x = pk2(acc[8], acc[9]); o1.y = pk2(acc[10], acc[11]); o1.z = pk2(acc[12], acc[13]); o1.w = pk2(acc[14], acc[15]);
        GAS v4u* dst = (GAS v4u*)(F.WOUT + (size_t)n * D + 512 + g * 128 + c0);
        dst[0] = o0; dst[1] = o1;
    }
}

template <bool GATES>
__device__ __forceinline__ void rows_norm_mod(Frame& F, const float* X, const float* gvec, int sh_off, int sc_off, bf16* Hout) {
    const int lane = F.lane;
    LAS f32x4* WGl = (LAS f32x4*)(F.lds + RING_OFF);
    if (GATES) {
        for (int idx = F.tid; idx < 4096; idx += NWAVES * 64) { const int l = idx & 63, t = idx >> 6, cq = t & 3, i = (t >> 2) & 3, j = t >> 4;
            WGl[idx] = *(const GAS f32x4*)(F.w_in + (size_t)(4 * l + 256 * j + i) * DIN + 2048 + 4 * cq); }
        __syncthreads();
    }
    const int NGW = F.G * NWAVES;
    for (int gw = F.vcu * NWAVES + F.wave; gw < M / 16; gw += NGW) {
        const int m0 = gw * 16, b = m0 / SEQ;
        f32x4 gs[4], sh[4];
#pragma unroll
        for (int j = 0; j < 4; ++j) { const int k = 4 * lane + 256 * j;
            const f32x4 g = *(const GAS f32x4*)(gvec + k), sc = *(const GAS f32x4*)(F.mod + b * 6144 + sc_off + k);
            gs[j] = g * (1.0f + sc); sh[j] = *(const GAS f32x4*)(F.mod + b * 6144 + sh_off + k); }
#pragma unroll 1
        for (int rg = 0; rg < 4; ++rg) {
            f32x4 xv[4][4]; float rstd[4];
#pragma unroll
            for (int r = 0; r < 4; ++r) { const GAS f32x4* xr = (const GAS f32x4*)(X + (size_t)(m0 + rg * 4 + r) * D) + lane;
#pragma unroll
                for (int j = 0; j < 4; ++j) xv[r][j] = xr[64 * j]; }
#pragma unroll
            for (int r = 0; r < 4; ++r) { float s = 0.f;
#pragma unroll
                for (int j = 0; j < 4; ++j) s += (xv[r][j].x * xv[r][j].x + xv[r][j].y * xv[r][j].y) + (xv[r][j].z * xv[r][j].z + xv[r][j].w * xv[r][j].w);
                rstd[r] = 1.0f / sqrtf(wave_sum(s) * (1.0f / D) + EPS); }
#pragma unroll
            for (int r = 0; r < 4; ++r) { GAS unsigned long long* o8 = (GAS unsigned long long*)(Hout + (size_t)(m0 + rg * 4 + r) * D) + lane;
#pragma unroll
                for (int j = 0; j < 4; ++j) { xv[r][j] = xv[r][j] * rstd[r] * gs[j] + sh[j];
                    o8[64 * j] = (unsigned long long)pk2(xv[r][j].x, xv[r][j].y) | ((unsigned long long)pk2(xv[r][j].z, xv[r][j].w) << 32); } }
            if (GATES) {
                float v[64];
#pragma unroll
                for (int q = 0; q < 64; ++q) v[q] = 0.f;
#pragma unroll
                for (int j = 0; j < 4; ++j)
#pragma unroll
                    for (int i = 0; i < 4; ++i)
#pragma unroll
                        for (int cq = 0; cq < 4; ++cq) { const f32x4 wv = WGl[((j * 4 + i) * 4 + cq) * 64 + lane];
#pragma unroll
                            for (int r = 0; r < 4; ++r) { const float hv = xv[r][j][i];
                                v[r * 16 + 4 * cq + 0] += hv * wv.x; v[r * 16 + 4 * cq + 1] += hv * wv.y; v[r * 16 + 4 * cq + 2] += hv * wv.z; v[r * 16 + 4 * cq + 3] += hv * wv.w; }
                            if (cq == 3) asm volatile("" ::: "memory"); }
#pragma unroll
                for (int half = 32; half >= 1; half >>= 1) { const bool up = (lane & half) != 0;
#pragma unroll
                    for (int i = 0; i < half; ++i) { const float keep = up ? v[i + half] : v[i], send = up ? v[i] : v[i + half]; v[i] = keep + __shfl_xor(send, half); } }
                const int r = lane >> 4, cidx = lane & 15, dir = cidx >> 3, gate = (cidx >> 2) & 1, head = cidx & 3;
                float val = v[0];
                if (gate == 0) val += F.b_ig[dir * NH + head];
                else { const float z = val + F.b_fg[dir * NH + head]; val = fminf(z, 0.f) - log1pf(__expf(-fabsf(z))); }
                F.GT[(size_t)cidx * M + m0 + rg * 4 + r] = val;
            }
        }
    }
}

namespace scan {
constexpr int KP = 136;
constexpr int OFF_K = 0, OFF_KT = 34816, OFF_VT = 69632, OFF_CT = 82688, OFF_TAB = 95744;
constexpr int TAB_BYTES = 5 * 128 * 4;
static_assert(OFF_TAB + 8 * TAB_BYTES <= RING_BYTES, "scan LDS map");
typedef float f32x2 __attribute__((ext_vector_type(2)));
typedef unsigned u32x2 __attribute__((ext_vector_type(2)));

__device__ __forceinline__ void scan_item(Frame& F, int item) {
    const int tid = F.tid, lane = F.lane, wave = F.wave, l15 = lane & 15, kq = lane >> 4;
    const int j = item & 3, dir = (item >> 2) & 1, h = (item >> 3) & 3, b = item >> 5;
    LAS unsigned char* L = F.lds + RING_OFF;
    LAS bf16* Kl = (LAS bf16*)(L + OFF_K); LAS bf16* Ktl = (LAS bf16*)(L + OFF_KT); LAS bf16* Vtl = (LAS bf16*)(L + OFF_VT); LAS bf16* Ctl = (LAS bf16*)(L + OFF_CT);
    LAS float* tab = (LAS float*)(L + OFF_TAB + wave * TAB_BYTES);
    for (int i = tid; i < 16 * KP; i += NWAVES * 64) Vtl[32 * KP + i] = (i < KP) ? (bf16)0x3F80 : (bf16)0;
    for (int i = tid; i < 48 * KP; i += NWAVES * 64) Ctl[i] = 0;
    f32x4 Cacc[3];
#pragma unroll
    for (int e = 0; e < 3; ++e) Cacc[e] = (f32x4){0.f, 0.f, 0.f, 0.f};
    float mcar = 0.f;
    const float* gli = F.GT + (size_t)(dir * 8 + 0 + h) * M + (size_t)b * SEQ;
    const float* glf = F.GT + (size_t)(dir * 8 + 4 + h) * M + (size_t)b * SEQ;
    float* Hout = dir ? F.HB : F.HF;
    const size_t rowb = (size_t)b * SEQ;
#pragma unroll 1
    for (int cc = 0; cc < NCHUNK; ++cc) {
        const int ci = dir ? (NCHUNK - 1 - cc) : cc, t0 = ci * CHUNK;
#define ROWOF(i) (t0 + (dir ? (CHUNK - 1 - (i)) : (i)))
        { const int i = tid >> 2, qd = tid & 3; const size_t grow = rowb + ROWOF(i);
          const GAS v4u* src = (const GAS v4u*)(F.KB + grow * DML + h * DH + qd * 32);
          v4u kv[4];
#pragma unroll
          for (int c = 0; c < 4; ++c) kv[c] = src[c];
          const GAS v4u* vsrc = (const GAS v4u*)(F.VB + grow * DML + h * DH + j * 32 + qd * 8);
          const v4u vv = vsrc[0];
#pragma unroll
          for (int c = 0; c < 4; ++c) { *(LAS v4u*)(Kl + i * KP + qd * 32 + c * 8) = kv[c];
#pragma unroll
              for (int q = 0; q < 4; ++q) { const unsigned w = kv[c][q]; const int d = qd * 32 + c * 8 + 2 * q;
                  Ktl[d * KP + i] = (bf16)(w & 0xffffu); Ktl[(d + 1) * KP + i] = (bf16)(w >> 16); } }
#pragma unroll
          for (int q = 0; q < 4; ++q) { const unsigned w = vv[q]; const int e = qd * 8 + 2 * q;
              Vtl[e * KP + i] = (bf16)(w & 0xffffu); Vtl[(e + 1) * KP + i] = (bf16)(w >> 16); }
        }
        bf16x8 Qf[4];
        { const size_t grow = rowb + ROWOF(16 * wave + l15); const GAS bf16x8* qs = (const GAS bf16x8*)(F.QB + grow * DML + h * DH + 8 * kq);
#pragma unroll
          for (int s = 0; s < 4; ++s) Qf[s] = qs[4 * s]; }
        float decay;
        { float li0, li1, lf0, lf1;
          if (dir) { const f32x2 a = *(const GAS f32x2*)(gli + t0 + 126 - 2 * lane), c = *(const GAS f32x2*)(glf + t0 + 126 - 2 * lane); li0 = a.y; li1 = a.x; lf0 = c.y; lf1 = c.x; }
          else     { const f32x2 a = *(const GAS f32x2*)(gli + t0 + 2 * lane), c = *(const GAS f32x2*)(glf + t0 + 2 * lane); li0 = a.x; li1 = a.y; lf0 = c.x; lf1 = c.y; }
          const float p = lf0 + lf1; float inc = p;
#pragma unroll
          for (int o = 1; o < 64; o <<= 1) { const float t = __shfl_up(inc, o); if (lane >= o) inc += t; }
          const float b0 = (inc - p) + lf0, b1 = b0 + lf1;
          const float a0 = li0 - b0, a1 = li1 - b1;
          float mx = fmaxf(a0, a1);
#pragma unroll
          for (int o = 1; o < 64; o <<= 1) { const float t = __shfl_up(mx, o); if (lane >= o) mx = fmaxf(mx, t); }
          float ex = __shfl_up(mx, 1); if (lane == 0) ex = -INFINITY;
          const float cm0 = fmaxf(ex, a0), cm1 = fmaxf(cm0, a1);
          const float u0 = fmaxf(mcar, cm0), u1 = fmaxf(mcar, cm1);
          const float ulast = __shfl(u1, 63), blast = __shfl(b1, 63);
          *(LAS f32x2*)(tab + 0 * 128 + 2 * lane) = (f32x2){a0 * LOG2E, a1 * LOG2E};
          *(LAS f32x2*)(tab + 1 * 128 + 2 * lane) = (f32x2){u0 * LOG2E, u1 * LOG2E};
          *(LAS f32x2*)(tab + 2 * 128 + 2 * lane) = (f32x2){__expf(mcar - u0), __expf(mcar - u1)};
          *(LAS f32x2*)(tab + 3 * 128 + 2 * lane) = (f32x2){__expf(-(b0 + u0)), __expf(-(b1 + u1))};
          *(LAS f32x2*)(tab + 4 * 128 + 2 * lane) = (f32x2){__expf(a0 - ulast), __expf(a1 - ulast)};
          decay = __expf(mcar - ulast); mcar = blast + ulast; }
        __syncthreads();
        f32x4 ST[8];
#pragma unroll
        for (int sg = 0; sg < 8; ++sg) { f32x4 a = (f32x4){0.f, 0.f, 0.f, 0.f};
#pragma unroll
            for (int s = 0; s < 4; ++s) { const bf16x8 kf = *(const LAS bf16x8*)(Kl + (16 * sg + l15) * KP + 32 * s + 8 * kq);
                a = __builtin_amdgcn_mfma_f32_16x16x32_bf16(kf, Qf[s], a, 0, 0, 0); }
            ST[sg] = a; }
        const int tl = 16 * wave + l15; const float ut = tab[1 * 128 + tl];
        v4u Pk[4];
#pragma unroll
        for (int sg = 0; sg < 8; ++sg) { const f32x4 as = *(const LAS f32x4*)(tab + 0 * 128 + 16 * sg + 4 * kq); float pv[4];
#pragma unroll
            for (int r = 0; r < 4; ++r) { const int s = 16 * sg + 4 * kq + r; const float w = __builtin_amdgcn_exp2f(fminf(as[r] - ut, 0.f)); pv[r] = (s <= tl) ? ST[sg][r] * w : 0.f; }
            Pk[sg >> 1][(sg & 1) * 2 + 0] = pk2(pv[0], pv[1]); Pk[sg >> 1][(sg & 1) * 2 + 1] = pk2(pv[2], pv[3]); }
        f32x4 Oa[3], C2[3];
#pragma unroll
        for (int e = 0; e < 3; ++e) { f32x4 o = (f32x4){0.f, 0.f, 0.f, 0.f}, c2 = (f32x4){0.f, 0.f, 0.f, 0.f};
#pragma unroll
            for (int i = 0; i < 4; ++i) { const LAS bf16* vr = Vtl + (16 * e + l15) * KP + 32 * i + 4 * kq;
                const u32x2 lo = *(const LAS u32x2*)(vr), hi = *(const LAS u32x2*)(vr + 16);
                const v4u vb = (v4u){lo.x, lo.y, hi.x, hi.y};
                o = __builtin_amdgcn_mfma_f32_16x16x32_bf16(__builtin_bit_cast(bf16x8, Pk[i]), __builtin_bit_cast(bf16x8, vb), o, 0, 0, 0);
                const bf16x8 cf = *(const LAS bf16x8*)(Ctl + (16 * e + l15) * KP + 32 * i + 8 * kq);
                c2 = __builtin_amdgcn_mfma_f32_16x16x32_bf16(Qf[i], cf, c2, 0, 0, 0); }
            Oa[e] = o; C2[e] = c2; }
        { const f32x4 ai = *(const LAS f32x4*)(tab + 2 * 128 + 16 * wave + 4 * kq), fl = *(const LAS f32x4*)(tab + 3 * 128 + 16 * wave + 4 * kq);
          f32x4 tot[3];
#pragma unroll
          for (int e = 0; e < 3; ++e) tot[e] = Oa[e] + ai * C2[e];
#pragma unroll
          for (int r = 0; r < 4; ++r) { const float den = __shfl(tot[2][r], lane & 48); const float inv = 1.0f / fmaxf(fabsf(den), fl[r]);
              const size_t grow = rowb + ROWOF(16 * wave + 4 * kq + r); float* hp = Hout + grow * DML + h * DH + j * 32 + l15;
              hp[0] = tot[0][r] * inv; hp[16] = tot[1][r] * inv; } }
        __syncthreads();
#pragma unroll
        for (int e = 0; e < 3; ++e) Cacc[e] = Cacc[e] * decay;
#pragma unroll
        for (int i = 0; i < 4; ++i) { const v4u kraw = *(const LAS v4u*)(Ktl + (16 * wave + l15) * KP + 32 * i + 8 * kq);
            const f32x4 w0 = *(const LAS f32x4*)(tab + 4 * 128 + 32 * i + 8 * kq), w1 = *(const LAS f32x4*)(tab + 4 * 128 + 32 * i + 8 * kq + 4);
            v4u ks; ks.x = pk2(bflo(kraw.x) * w0.x, bfhi(kraw.x) * w0.y); ks.y = pk2(bflo(kraw.y) * w0.z, bfhi(kraw.y) * w0.w);
            ks.z = pk2(bflo(kraw.z) * w1.x, bfhi(kraw.z) * w1.y); ks.w = pk2(bflo(kraw.w) * w1.z, bfhi(kraw.w) * w1.w);
#pragma unroll
            for (int e = 0; e < 3; ++e) { const bf16x8 vf = *(const LAS bf16x8*)(Vtl + (16 * e + l15) * KP + 32 * i + 8 * kq);
                Cacc[e] = __builtin_amdgcn_mfma_f32_16x16x32_bf16(__builtin_bit_cast(bf16x8, ks), vf, Cacc[e], 0, 0, 0); } }
#pragma unroll
        for (int e = 0; e < 3; ++e) { u32x2 w; w.x = pk2(Cacc[e][0], Cacc[e][1]); w.y = pk2(Cacc[e][2], Cacc[e][3]);
            *(LAS u32x2*)(Ctl + (16 * e + l15) * KP + 16 * wave + 4 * kq) = w; }
        __syncthreads();
#undef ROWOF
    }
}
}

__device__ __forceinline__ void p4_combine(Frame& F) {
    const int lane = F.lane, NGW = F.G * NWAVES, grp = lane >> 4, hw = 1 << grp;
    f32x4 gh[2];
    gh[0] = *(const GAS f32x4*)(F.g_head + 8 * lane); gh[1] = *(const GAS f32x4*)(F.g_head + 8 * lane + 4);
    for (int gw = F.vcu * NWAVES + F.wave; gw < M / 16; gw += NGW) {
#pragma unroll 1
        for (int rr = 0; rr < 16; ++rr) {
            const int m = gw * 16 + rr, t = m % SEQ; const size_t mb = (size_t)(m - t);
            const GAS f32x4* pf = (const GAS f32x4*)(F.HF + (size_t)m * DML + 8 * lane); const GAS f32x4* pb = (const GAS f32x4*)(F.HB + (size_t)m * DML + 8 * lane);
            f32x4 h0 = pf[0] + pb[0], h1 = pf[1] + pb[1];
            float ss = (h0.x * h0.x + h0.y * h0.y) + (h0.z * h0.z + h0.w * h0.w) + (h1.x * h1.x + h1.y * h1.y) + (h1.z * h1.z + h1.w * h1.w);
            ss += __shfl_xor(ss, 1); ss += __shfl_xor(ss, 2); ss += __shfl_xor(ss, 4); ss += __shfl_xor(ss, 8);
            const float rs = 1.0f / sqrtf(ss * (1.0f / DH) + EPS);
            const v4u ov = *(const GAS v4u*)(F.OB + (size_t)m * DML + 8 * lane);
            h0 = h0 * rs * gh[0]; h1 = h1 * rs * gh[1];
            v4u ya; ya.x = pk2(h0.x * bflo(ov.x), h0.y * bfhi(ov.x)); ya.y = pk2(h0.z * bflo(ov.y), h0.w * bfhi(ov.y));
            ya.z = pk2(h1.x * bflo(ov.z), h1.y * bfhi(ov.z)); ya.w = pk2(h1.z * bflo(ov.w), h1.w * bfhi(ov.w));
            *(GAS v4u*)(F.HBUF + (size_t)m * D + 8 * lane) = ya;
            const int lo = max(t - hw, 0), hi = min(t + hw, SEQ);
            float s[8];
#pragma unroll
            for (int q = 0; q < 8; ++q) s[q] = 0.f;
            for (int ts = lo; ts < hi; ++ts) { const v4u uv = *(const GAS v4u*)(F.UB + (mb + ts) * DML + 8 * lane);
                s[0] += bflo(uv.x); s[1] += bfhi(uv.x); s[2] += bflo(uv.y); s[3] += bfhi(uv.y); s[4] += bflo(uv.z); s[5] += bfhi(uv.z); s[6] += bflo(uv.w); s[7] += bfhi(uv.w); }
            const v4u uc = *(const GAS v4u*)(F.UB + (size_t)m * DML + 8 * lane);
            const float ic = 1.0f / (float)(hi - lo);
            v4u yb; yb.x = pk2(s[0] * ic - bflo(uc.x), s[1] * ic - bfhi(uc.x)); yb.y = pk2(s[2] * ic - bflo(uc.y), s[3] * ic - bfhi(uc.y));
            yb.z = pk2(s[4] * ic - bflo(uc.z), s[5] * ic - bfhi(uc.z)); yb.w = pk2(s[6] * ic - bflo(uc.w), s[7] * ic - bfhi(uc.w));
            *(GAS v4u*)(F.HBUF + (size_t)m * D + 512 + 8 * lane) = yb;
        }
    }
}

__device__ __forceinline__ void p9_final(Frame& F) {
    const int lane = F.lane, NGW = F.G * NWAVES;
    f32x4 g[4];
#pragma unroll
    for (int j = 0; j < 4; ++j) g[j] = *(const GAS f32x4*)(F.g_final + 4 * lane + 256 * j);
    for (int m = F.vcu * NWAVES + F.wave; m < M; m += NGW) {
        GAS f32x4* xr = (GAS f32x4*)(F.out + (size_t)m * D) + lane;
        f32x4 v[4]; float s = 0.f;
#pragma unroll
        for (int j = 0; j < 4; ++j) { v[j] = xr[64 * j]; s += (v[j].x * v[j].x + v[j].y * v[j].y) + (v[j].z * v[j].z + v[j].w * v[j].w); }
        const float rstd = 1.0f / sqrtf(wave_sum(s) * (1.0f / D) + EPS);
#pragma unroll
        for (int j = 0; j < 4; ++j) xr[64 * j] = v[j] * rstd * g[j];
    }
}

struct Args { const float* in[16]; float* out; unsigned char* ws; int ph_lo, ph_hi, li, pad; };
__global__ void __launch_bounds__(NWAVES * 64, 2) mk_fwd(Args args) {
    extern __shared__ __attribute__((aligned(16))) unsigned char lds[];
    Frame F;
    F.lds = (LAS unsigned char*)lds;
    F.MISC = (volatile LAS unsigned*)(F.lds + MISC_OFF);
    F.tid = threadIdx.x; F.lane = F.tid & 63; F.wave = __builtin_amdgcn_readfirstlane(F.tid >> 6);
    F.G = gridDim.x; { const int bx = blockIdx.x; F.vcu = (F.G % 8 == 0) ? (bx % 8) * (F.G / 8) + bx / 8 : bx; }
#define GRID_BAR(seam) do { if (N_LAUNCHES == PER_PHASE) { if (F.tid == 0) __hip_atomic_store(F.ctl + CW_TMO, 0xBADBA0u | (unsigned)(seam), RLX_AGENT); } \
    else { xcd_barrier(bar); } } while (0)
    unsigned char* ws = args.ws;
    F.ctl = (gu32*)(ws + WS_CTL);
    F.x = args.in[0]; F.c = args.in[1]; F.w_ada = args.in[2]; F.b_ada = args.in[3]; F.g_mix = args.in[4]; F.w_in = args.in[5]; F.b_ig = args.in[6]; F.b_fg = args.in[7];
    F.g_head = args.in[8]; F.w_pool = args.in[9]; F.pool_scale = args.in[10]; F.w_out = args.in[11]; F.g_ffn = args.in[12]; F.w_ff1 = args.in[13]; F.w_ff2 = args.in[14]; F.g_final = args.in[15];
    F.out = args.out;
    F.mod = (float*)(ws + WS_MOD); F.GT = (float*)(ws + WS_GT); F.HF = (float*)(ws + WS_HF); F.HB = (float*)(ws + WS_HB);
    F.WIN = (bf16*)(ws + WS_WIN); F.WOUT = (bf16*)(ws + WS_WOUT); F.W1 = (bf16*)(ws + WS_W1); F.W2 = (bf16*)(ws + WS_W2);
    F.HBUF = (bf16*)(ws + WS_H); F.QB = (bf16*)(ws + WS_Q); F.KB = (bf16*)(ws + WS_K); F.VB = (bf16*)(ws + WS_V); F.OB = (bf16*)(ws + WS_O); F.UB = (bf16*)(ws + WS_U); F.AB = (bf16*)(ws + WS_A);
    for (int u = F.tid; u < (LDS_BYTES - LDSCTL_OFF) / 4; u += NWAVES * 64) ((LAS unsigned*)(F.lds + LDSCTL_OFF))[u] = 0u;
    __syncthreads();
    XcdBarrier bar; bar.bar = (unsigned*)(F.ctl + CW_BAR); bar.x = 0; bar.st = nullptr;
    if (N_LAUNCHES != PER_PHASE) bar = xcd_barrier_post((unsigned*)(F.ctl + CW_BAR), F.MISC + 8);

    const int lo = args.ph_lo, hi = args.ph_hi;
#define IN(k) (lo <= (k) && (k) < hi)
#define BOTH(k) (IN(k) && IN((k) + 1))
    if (IN(0)) { p0_prologue(F); if (BOTH(0)) GRID_BAR(0); }
    if (IN(1)) { rows_norm_mod<true>(F, F.x, F.g_mix, 0 * D, 1 * D, F.HBUF); if (BOTH(1)) GRID_BAR(1); }
    if (IN(2)) {
        pg8::Gemm g{F.HBUF, F.WIN, M, NPROJ, D}; pg8::StaticOrder S; S.init(M, NPROJ, F.G, (int)blockIdx.x);
        pg8::EpiProj E{F.QB, (size_t)(WS_K - WS_Q) / 2};
        pg8::gemm_phase<pg8::EpiProj, pg8::StaticOrder, PG8_ALIGN, PG8_SP2>(F.lds + RING_OFF, g, S, E);
        if (BOTH(2)) GRID_BAR(2);
    }
    if (IN(3)) { for (int it = F.vcu; it < 256; it += F.G) scan::scan_item(F, it); if (BOTH(3)) GRID_BAR(3); }
    if (IN(4)) { p4_combine(F); if (BOTH(4)) GRID_BAR(4); }
    if (IN(5)) {
        pg8::Gemm g{F.HBUF, F.WOUT, M, D, D}; pg8::StaticOrder S; S.init(M, D, F.G, (int)blockIdx.x);
        pg8::EpiRes E{F.x, F.out, F.mod + 2 * D};
        pg8::gemm_phase<pg8::EpiRes, pg8::StaticOrder, PG8_ALIGN, PG8_SP2>(F.lds + RING_OFF, g, S, E);
        if (BOTH(5)) GRID_BAR(5);
    }
    if (IN(6)) { rows_norm_mod<false>(F, F.out, F.g_ffn, 3 * D, 4 * D, F.HBUF); if (BOTH(6)) GRID_BAR(6); }
    if (IN(7)) {
        pg8::Gemm g{F.HBUF, F.W1, M, FF, D}; pg8::StaticOrder S; S.init(M, FF, F.G, (int)blockIdx.x);
        pg8::EpiRelu2 E{F.AB, FF};
        pg8::gemm_phase<pg8::EpiRelu2, pg8::StaticOrder, PG8_ALIGN, PG8_SP2>(F.lds + RING_OFF, g, S, E);
        if (BOTH(7)) GRID_BAR(7);
    }
    if (IN(8)) {
        pg8::Gemm g{F.AB, F.W2, M, D, FF}; pg8::StaticOrder S; S.init(M, D, F.G, (int)blockIdx.x);
        pg8::EpiRes E{F.out, F.out, F.mod + 5 * D};
        pg8::gemm_phase<pg8::EpiRes, pg8::StaticOrder, PG8_ALIGN, PG8_SP2>(F.lds + RING_OFF, g, S, E);
        if (BOTH(8)) GRID_BAR(8);
    }
    if (IN(9)) { p9_final(F); }
#undef IN
#undef BOTH
}

extern "C" void kernel_launch(void* const* d_in, const int* in_sizes, int n_in, void* d_out, int out_size, void* d_ws, size_t ws_size, hipStream_t stream) {
    static int grid = 0;
    if (grid == 0) {
        if (n_in != 16 || in_sizes[0] != M * D || out_size != M * D || ws_size < WS_END) { fprintf(stderr, "kernel_launch: unexpected shapes (n_in %d in0 %d out %d ws %zu); nothing launched\n", n_in, n_in > 0 ? in_sizes[0] : -1, out_size, ws_size); grid = -1; return; }
        int dev = 0, cus = 0, per_cu = 0;
        if (hipGetDevice(&dev) != hipSuccess || hipDeviceGetAttribute(&cus, hipDeviceAttributeMultiprocessorCount, dev) != hipSuccess) { grid = -1; return; }
        if (hipFuncSetAttribute((const void*)mk_fwd, hipFuncAttributeMaxDynamicSharedMemorySize, LDS_BYTES) != hipSuccess) { fprintf(stderr, "kernel_launch: hipFuncSetAttribute failed\n"); grid = -1; return; }
        if (hipOccupancyMaxActiveBlocksPerMultiprocessor(&per_cu, (const void*)mk_fwd, NWAVES * 64, LDS_BYTES) != hipSuccess || per_cu < 1)
            fprintf(stderr, "kernel_launch: note: occupancy query reports %d workgroups per CU\n", per_cu);
        (void)hipGetLastError();
        grid = cus;
    }
    if (grid < 0) return;
    if (hipMemsetAsync((char*)d_ws + WS_CTL, 0, CTL_ZERO_BYTES, stream) != hipSuccess) { fprintf(stderr, "kernel_launch: hipMemsetAsync failed\n"); return; }
    Args a{};
    for (int i = 0; i < 16; ++i) a.in[i] = (const float*)d_in[i];
    a.out = (float*)d_out; a.ws = (unsigned char*)d_ws;
    for (int li = 0; li < N_LAUNCHES; ++li) {
        a.ph_lo = (N_LAUNCHES == PER_PHASE) ? li : 0; a.ph_hi = (N_LAUNCHES == PER_PHASE) ? li + 1 : PER_PHASE; a.li = li;
        hipLaunchKernelGGL(mk_fwd, dim3(grid), dim3(NWAVES * 64), LDS_BYTES, stream, a);
        const hipError_t le = hipPeekAtLastError();
        if (le != hipSuccess) { fprintf(stderr, "kernel_launch: launch %d failed: %s\n", li, hipGetErrorName(le)); break; }
    }
}
```

```cpp
#include <hip/hip_runtime.h>
#include <cstdio>
#include <cstdint>
namespace pg8 {
#define PG8_LAS __attribute__((address_space(3)))
typedef unsigned short bf16_t;
typedef short bf16x8 __attribute__((ext_vector_type(8)));
typedef float f32x4 __attribute__((ext_vector_type(4)));
typedef unsigned u32x4 __attribute__((ext_vector_type(4)));
constexpr int BM = 256, BK = 64, HALF = 128, HTB = HALF * BK * 2  , STAGE_BYTES = 8 * HTB, NXCD = 8, WGM = 8;

__host__ __device__ __forceinline__ int lds_byte(int r, int c) { const int st = (r >> 4) * 2 + (c >> 5), rr = r & 15, cc = c & 31, ob = rr * 64 + cc * 2; return st * 1024 + (ob ^ (((ob >> 9) & 1) << 5)); }
__host__ __device__ __forceinline__ void stage_rc(int b, int& R, int& C) { const int st = b / 1024, sb = b % 1024, swz = sb ^ (((sb >> 9) & 1) << 5); R = (st >> 1) * 16 + swz / 64; C = (st & 1) * 32 + (swz % 64) / 2; }
__host__ __device__ __forceinline__ int perm32(int rho) { const int n = rho >> 4, i = rho & 15; return 8 * (i >> 2) + 4 * n + (i & 3); }

struct Unit { int pm, pn; };
struct Gemm { const bf16_t* A; const bf16_t* Bt; int M, N, K; };

struct StaticOrder {
    int nM, nN, nwg, G, c;
    __host__ __device__ void init(int M, int N, int G_, int c_) { nM = M / BM; nN = N / BM; nwg = nM * nN; G = G_; c = c_; }
    __host__ __device__ bool next(int i, Unit& u) const {
        const long L = (long)i * G + c; if (L >= nwg) return false;
        int wgid = (int)L; { const int q = nwg / NXCD, r = nwg % NXCD, xcd = wgid % NXCD, off = wgid / NXCD; wgid = (xcd < r ? xcd * (q + 1) : r * (q + 1) + (xcd - r) * q) + off; }
        const int nig = WGM * nN, gid = wgid / nig, fm = gid * WGM, gsz = (nM - fm) < WGM ? (nM - fm) : WGM;
        u.pm = fm + ((wgid % nig) % gsz); u.pn = (wgid % nig) / gsz; return true;
    }
    __device__ __forceinline__ void a_ready(const Unit&) const {}
    __device__ __forceinline__ void done(const Unit&) const {}
};


__device__ __forceinline__ unsigned cvt_pk_bf16(float lo, float hi) { unsigned r; asm volatile("v_cvt_pk_bf16_f32 %0, %1, %2" : "=v"(r) : "v"(lo), "v"(hi)); return r; }
__device__ __forceinline__ float sigmoidf_fast(float x) { return __builtin_amdgcn_rcpf(1.0f + __builtin_amdgcn_exp2f(-1.4426950408889634f * x)); }

struct EpiProj {
    static constexpr bool PERM = true, AFTER_DRAIN = false;
    bf16_t* O; size_t split_stride;
    __device__ __forceinline__ void operator()(const f32x4 (&acc)[2][2][4][2], const Unit& u, int wr, int wc, int fr, int fq) const {
        const int row0 = u.pm * BM + wr * 64 + fr; const int t = u.pn >> 1;
        bf16_t* base = O + (size_t)t * split_stride;
        const int col0 = (u.pn & 1) * 256 + wc * 32 + 8 * fq;
        const float sc = (t == 0) ? 0.08838834764831845f : 1.0f;
#pragma unroll
        for (int ai = 0; ai < 2; ++ai)
#pragma unroll
            for (int m = 0; m < 4; ++m) { bf16_t* rowp = base + (size_t)(row0 + ai * HALF + m * 16) * 512 + col0;
#pragma unroll
                for (int bj = 0; bj < 2; ++bj) { f32x4 v0 = acc[ai][bj][m][0] * sc, v1 = acc[ai][bj][m][1] * sc;
                    if (t == 3) {
#pragma unroll
                        for (int q = 0; q < 4; ++q) { v0[q] = sigmoidf_fast(v0[q]); v1[q] = sigmoidf_fast(v1[q]); } }
                    u32x4 w; w.x = cvt_pk_bf16(v0[0], v0[1]); w.y = cvt_pk_bf16(v0[2], v0[3]); w.z = cvt_pk_bf16(v1[0], v1[1]); w.w = cvt_pk_bf16(v1[2], v1[3]);
                    *(u32x4*)(rowp + bj * HALF) = w; } }
    }
};
struct EpiRelu2 {
    static constexpr bool PERM = true, AFTER_DRAIN = false;
    bf16_t* O; int ldc;
    __device__ __forceinline__ void operator()(const f32x4 (&acc)[2][2][4][2], const Unit& u, int wr, int wc, int fr, int fq) const {
        const int row0 = u.pm * BM + wr * 64 + fr; const int col0 = u.pn * BM + wc * 32 + 8 * fq;
#pragma unroll
        for (int ai = 0; ai < 2; ++ai)
#pragma unroll
            for (int m = 0; m < 4; ++m) { bf16_t* rowp = O + (size_t)(row0 + ai * HALF + m * 16) * ldc + col0;
#pragma unroll
                for (int bj = 0; bj < 2; ++bj) { f32x4 v0 = acc[ai][bj][m][0], v1 = acc[ai][bj][m][1];
#pragma unroll
                    for (int q = 0; q < 4; ++q) { const float a = fmaxf(v0[q], 0.f), b = fmaxf(v1[q], 0.f); v0[q] = a * a; v1[q] = b * b; }
                    u32x4 w; w.x = cvt_pk_bf16(v0[0], v0[1]); w.y = cvt_pk_bf16(v0[2], v0[3]); w.z = cvt_pk_bf16(v1[0], v1[1]); w.w = cvt_pk_bf16(v1[2], v1[3]);
                    *(u32x4*)(rowp + bj * HALF) = w; } }
    }
};
struct EpiRes {
    static constexpr bool PERM = false, AFTER_DRAIN = false;
    const float* base; float* out; const float* gate;
    __device__ __forceinline__ void operator()(const f32x4 (&acc)[2][2][4][2], const Unit& u, int wr, int wc, int fr, int fq) const {
        const int row0 = u.pm * BM + wr * 64 + fr, col0 = u.pn * BM + wc * 32 + 4 * fq;
        const float* gv = gate + (size_t)(u.pm >> 4) * 6144 + col0;
        f32x4 g[2][2];
#pragma unroll
        for (int bj = 0; bj < 2; ++bj)
#pragma unroll
            for (int n = 0; n < 2; ++n) g[bj][n] = *(const f32x4*)(gv + bj * HALF + n * 16);
#pragma unroll
        for (int ai = 0; ai < 2; ++ai)
#pragma unroll
            for (int m = 0; m < 4; ++m) { const size_t off = (size_t)(row0 + ai * HALF + m * 16) * 1024 + col0;
#pragma unroll
                for (int bj = 0; bj < 2; ++bj)
#pragma unroll
                    for (int n = 0; n < 2; ++n) { const f32x4 bs = *(const f32x4*)(base + off + bj * HALF + n * 16);
                        *(f32x4*)(out + off + bj * HALF + n * 16) = bs + g[bj][n] * acc[ai][bj][m][n]; }
                if (m & 1) asm volatile("" ::: "memory"); }
    }
};

template <class Epi, class Sched, bool ALIGN_EPI = false, bool SP2 = false>
__device__ __forceinline__ void gemm_phase(PG8_LAS unsigned char* lds, const Gemm g, const Sched& S, const Epi& E) {
    const int tid = threadIdx.x, wid = __builtin_amdgcn_readfirstlane(tid >> 6), lane = tid & 63, wr = wid >> 2, wc = wid & 3, fr = lane & 15, fq = lane >> 4;
    const int K = g.K, nt = K / BK;
    unsigned voffA[2], voffB[2];
#pragma unroll
    for (int i = 0; i < 2; ++i) { int R, C; stage_rc(tid * 16 + i * 8192, R, C); const int Rb = Epi::PERM ? ((R & ~31) + perm32(R & 31)) : R;
        voffA[i] = (unsigned)(R * K + C) * 2u; voffB[i] = (unsigned)(Rb * K + C) * 2u; }
    const size_t kstep = (size_t)(BK * 2);
    const size_t hstep = (size_t)HALF * K * 2;
    const size_t tstep = 2 * hstep;
    const unsigned ldsw = (unsigned)wid * 1024u;
    const int aoff = lds_byte(wr * 64 + fr, fq * 8), boff = lds_byte(wc * 32 + fr, fq * 8);
#define PG8_SA(b, h) (((b) * 2 + (h)) * HTB)
#define PG8_SB(b, h) ((4 + (b) * 2 + (h)) * HTB)
#define PG8_STAGE(bufoff, gbase, voff) do { _Pragma("unroll") for (int _i = 0; _i < 2; ++_i) \
        __builtin_amdgcn_global_load_lds((const unsigned*)((const char*)(gbase) + (voff)[_i]), (PG8_LAS unsigned*)(lds + (bufoff) + ldsw + _i * 8192), 16, 0, 0); } while (0)
#define PG8_LDA(dst, b, h) do { _Pragma("unroll") for (int m = 0; m < 4; ++m) _Pragma("unroll") for (int k = 0; k < 2; ++k) dst[m][k] = *(const PG8_LAS bf16x8*)(lds + PG8_SA(b, h) + aoff + m * 2048 + k * 1024); } while (0)
#define PG8_LDB(dst, b, h) do { _Pragma("unroll") for (int n = 0; n < 2; ++n) _Pragma("unroll") for (int k = 0; k < 2; ++k) dst[n][k] = *(const PG8_LAS bf16x8*)(lds + PG8_SB(b, h) + boff + n * 2048 + k * 1024); } while (0)
#define PG8_MMA(ai, bj, At, Bt) do { __builtin_amdgcn_s_setprio(1); _Pragma("unroll") for (int m = 0; m < 4; ++m) _Pragma("unroll") for (int n = 0; n < 2; ++n) _Pragma("unroll") for (int k = 0; k < 2; ++k) \
        acc[ai][bj][m][n] = __builtin_amdgcn_mfma_f32_16x16x32_bf16(Bt[n][k], At[m][k], acc[ai][bj][m][n], 0, 0, 0); __builtin_amdgcn_s_setprio(0); } while (0)
#define PG8_WAIT_V(n) asm volatile("s_waitcnt vmcnt(" #n ")" ::: "memory")
#define PG8_WAIT_L(n) asm volatile("s_waitcnt lgkmcnt(" #n ")" ::: "memory")
#define PG8_BAR __builtin_amdgcn_s_barrier()
#define PG8_SCHED __builtin_amdgcn_sched_barrier(0)
    Unit cur, nxt; int ui = 0;
    if (!S.next(0, cur)) return;
    f32x4 acc[2][2][4][2];
#pragma unroll
    for (int a = 0; a < 2; ++a)
#pragma unroll
        for (int b = 0; b < 2; ++b)
#pragma unroll
            for (int m = 0; m < 4; ++m)
#pragma unroll
                for (int n = 0; n < 2; ++n) acc[a][b][m][n] = (f32x4){0.f, 0.f, 0.f, 0.f};
    bf16x8 At[4][2], B0[2][2], B1[2][2];
    const char* cA = (const char*)g.A + (size_t)cur.pm * tstep; const char* cB = (const char*)g.Bt + (size_t)cur.pn * tstep;
    S.a_ready(cur);
    if constexpr (SP2) {
        PG8_STAGE(PG8_SB(0, 0), cB, voffB); PG8_STAGE(PG8_SB(0, 1), cB + hstep, voffB); PG8_STAGE(PG8_SA(0, 0), cA, voffA); PG8_STAGE(PG8_SA(0, 1), cA + hstep, voffA);
        if (wr == 1) PG8_BAR;
        PG8_WAIT_V(2); PG8_BAR;
        PG8_STAGE(PG8_SB(1, 0), cB + kstep, voffB); PG8_STAGE(PG8_SA(1, 0), cA + kstep, voffA); PG8_STAGE(PG8_SB(1, 1), cB + hstep + kstep, voffB);
        PG8_WAIT_V(6); PG8_BAR;
    } else {
        PG8_STAGE(PG8_SB(0, 0), cB, voffB); PG8_STAGE(PG8_SA(0, 0), cA, voffA); PG8_STAGE(PG8_SB(0, 1), cB + hstep, voffB); PG8_STAGE(PG8_SA(0, 1), cA + hstep, voffA);
        if (wr == 1) PG8_BAR;
        PG8_WAIT_V(4); PG8_BAR;
        PG8_STAGE(PG8_SB(1, 0), cB + kstep, voffB); PG8_STAGE(PG8_SA(1, 0), cA + kstep, voffA); PG8_STAGE(PG8_SB(1, 1), cB + hstep + kstep, voffB);
        PG8_WAIT_V(6); PG8_BAR;
    }
    for (;;) {
        const bool has_next = S.next(ui + 1, nxt);
        const char* nA = has_next ? (const char*)g.A + (size_t)nxt.pm * tstep : cA; const char* nB = has_next ? (const char*)g.Bt + (size_t)nxt.pn * tstep : cB;
        for (int t = 0; t < nt; t += 2) {
            const bool last = (t == nt - 2);
            const char* a1 = cA + (size_t)(t + 1) * kstep;
            const char* a2 = last ? nA : cA + (size_t)(t + 2) * kstep; const char* b2 = last ? nB : cB + (size_t)(t + 2) * kstep;
            const char* a3 = a2 + kstep; const char* b3 = b2 + kstep;
            if (last && has_next) S.a_ready(nxt);
            if constexpr (SP2) {
            PG8_LDB(B0, 0, 0); PG8_LDB(B1, 0, 1); PG8_SCHED; PG8_LDA(At, 0, 0); PG8_STAGE(PG8_SA(1, 1), a1 + hstep, voffA);
            PG8_WAIT_V(8); PG8_WAIT_L(0); PG8_BAR; PG8_MMA(0, 0, At, B0); PG8_MMA(0, 1, At, B1); PG8_BAR; PG8_SCHED;
            PG8_LDA(At, 0, 1); PG8_STAGE(PG8_SB(0, 0), b2, voffB); PG8_STAGE(PG8_SB(0, 1), b2 + hstep, voffB); PG8_STAGE(PG8_SA(0, 0), a2, voffA);
            PG8_WAIT_V(8); PG8_WAIT_L(0); PG8_BAR; PG8_MMA(1, 0, At, B0); PG8_MMA(1, 1, At, B1); PG8_BAR; PG8_SCHED;
            PG8_LDB(B0, 1, 0); PG8_LDB(B1, 1, 1); PG8_SCHED; PG8_LDA(At, 1, 0); PG8_STAGE(PG8_SA(0, 1), a2 + hstep, voffA);
            PG8_WAIT_V(8); PG8_WAIT_L(0); PG8_BAR; PG8_MMA(0, 0, At, B0); PG8_MMA(0, 1, At, B1); PG8_BAR; PG8_SCHED;
            PG8_LDA(At, 1, 1); PG8_STAGE(PG8_SB(1, 0), b3, voffB); PG8_STAGE(PG8_SB(1, 1), b3 + hstep, voffB); PG8_STAGE(PG8_SA(1, 0), a3, voffA);
            PG8_WAIT_V(8); PG8_WAIT_L(0); PG8_BAR; PG8_MMA(1, 0, At, B0); PG8_MMA(1, 1, At, B1); PG8_BAR; PG8_SCHED;
            } else {
            PG8_LDB(B0, 0, 0); PG8_SCHED; PG8_LDA(At, 0, 0); PG8_STAGE(PG8_SA(1, 1), a1 + hstep, voffA);
            PG8_WAIT_L(8); PG8_BAR; PG8_WAIT_L(0); PG8_MMA(0, 0, At, B0); PG8_BAR; PG8_SCHED;
            PG8_LDB(B1, 0, 1); PG8_STAGE(PG8_SB(0, 0), b2, voffB);
            PG8_BAR; PG8_WAIT_L(0); PG8_MMA(0, 1, At, B1); PG8_BAR;
            PG8_LDA(At, 0, 1); PG8_STAGE(PG8_SA(0, 0), a2, voffA);
            PG8_BAR; PG8_WAIT_L(0); PG8_MMA(1, 0, At, B0); PG8_BAR; PG8_SCHED;
            PG8_STAGE(PG8_SB(0, 1), b2 + hstep, voffB);
            PG8_WAIT_V(6); PG8_BAR; PG8_MMA(1, 1, At, B1); PG8_BAR;
            PG8_LDB(B0, 1, 0); PG8_SCHED; PG8_LDA(At, 1, 0); PG8_STAGE(PG8_SA(0, 1), a2 + hstep, voffA);
            PG8_WAIT_L(8); PG8_BAR; PG8_WAIT_L(0); PG8_MMA(0, 0, At, B0); PG8_BAR; PG8_SCHED;
            PG8_LDB(B1, 1, 1); PG8_STAGE(PG8_SB(1, 0), b3, voffB);
            PG8_BAR; PG8_WAIT_L(0); PG8_MMA(0, 1, At, B1); PG8_BAR;
            PG8_LDA(At, 1, 1); PG8_STAGE(PG8_SA(1, 0), a3, voffA);
            PG8_BAR; PG8_WAIT_L(0); PG8_MMA(1, 0, At, B0); PG8_BAR; PG8_SCHED;
            PG8_STAGE(PG8_SB(1, 1), b3 + hstep, voffB);
            PG8_WAIT_V(6); PG8_BAR; PG8_MMA(1, 1, At, B1); PG8_BAR;
            }
        }
        if constexpr (ALIGN_EPI) { if (wr == 0) PG8_BAR; }
        if constexpr (!Epi::AFTER_DRAIN) { E(acc, cur, wr, wc, fr, fq); S.done(cur); }
        if (!has_next) break;
#pragma unroll
        for (int a = 0; a < 2; ++a)
#pragma unroll
            for (int b = 0; b < 2; ++b)
#pragma unroll
                for (int m = 0; m < 4; ++m)
#pragma unroll
                    for (int n = 0; n < 2; ++n) acc[a][b][m][n] = (f32x4){0.f, 0.f, 0.f, 0.f};
        cur = nxt; cA = nA; cB = nB; ++ui;
        if constexpr (ALIGN_EPI) { if (wr == 1) PG8_BAR; }
    }
    PG8_WAIT_V(0);
    if constexpr (!ALIGN_EPI) { if (wr == 0) PG8_BAR; }
    PG8_BAR;
    if constexpr (Epi::AFTER_DRAIN) { E.fused(acc, cur, wr, wc, fr, fq, lds, wid, lane); S.done(cur); }
#undef PG8_SA
#undef PG8_SB
#undef PG8_STAGE
#undef PG8_LDA
#undef PG8_LDB
#undef PG8_MMA
#undef PG8_WAIT_V
#undef PG8_WAIT_L
#undef PG8_BAR
#undef PG8_SCHED
}
}
#ifndef PG8_SP2
#define PG8_SP2 true
#endif
#ifndef PG8_ALIGN
#define PG8_ALIGN true
#endif
constexpr int NWAVES = 8;
#ifndef MK_N_LAUNCHES
#define MK_N_LAUNCHES 1
#endif
constexpr int PER_PHASE = 10;
constexpr int N_LAUNCHES = MK_N_LAUNCHES;

constexpr int BATCH = 8, SEQ = 4096, D = 1024, M = BATCH * SEQ, DML = 512, NH = 4, DH = 128, DPOOL = 512, DIN = 2576, FF = 4096, CHUNK = 128, NCHUNK = SEQ / CHUNK;
constexpr int NPROJ = 2560;
constexpr float EPS = 1e-6f;
constexpr float LOG2E = 1.4426950408889634f;

constexpr size_t MiB = 1u << 20;
constexpr size_t WS_CTL = 0, CTL_ZERO_BYTES = 1 * MiB;
constexpr size_t WS_MOD = 1 * MiB;
constexpr size_t WS_WIN = 2 * MiB, WS_WOUT = 7 * MiB, WS_W1 = 9 * MiB, WS_W2 = 17 * MiB;
constexpr size_t WS_GT = 26 * MiB;
constexpr size_t WS_H = 32 * MiB;
constexpr size_t WS_Q = 96 * MiB, WS_K = 128 * MiB, WS_V = 160 * MiB, WS_O = 192 * MiB, WS_U = 224 * MiB;
constexpr size_t WS_HF = 256 * MiB, WS_HB = 320 * MiB;
constexpr size_t WS_A = 96 * MiB;
constexpr size_t WS_END = 384 * MiB;
constexpr int CW_TMO = 0, CW_CODE = 1;
constexpr int CW_BAR = 4096;

constexpr int RING_OFF = 0, RING_BYTES = 131072;
constexpr int LDSCTL_OFF = RING_BYTES, MISC_OFF = LDSCTL_OFF + 320;
constexpr int LDS_BYTES = 147456;
static_assert(MISC_OFF + 128 <= LDS_BYTES, "LDS map");

#define GAS __attribute__((address_space(1)))
#define LAS __attribute__((address_space(3)))
typedef unsigned short bf16;
typedef unsigned v4u __attribute__((ext_vector_type(4)));
typedef float f32x4 __attribute__((ext_vector_type(4)));
typedef short bf16x8 __attribute__((ext_vector_type(8)));
typedef GAS unsigned gu32;
typedef GAS unsigned long long gu64;
#define RLX_AGENT __ATOMIC_RELAXED, __HIP_MEMORY_SCOPE_AGENT
#define LDS_WAIT() asm volatile("s_waitcnt lgkmcnt(0)" ::: "memory")
#define VM_WAIT() asm volatile("s_waitcnt vmcnt(0)" ::: "memory")
__device__ __forceinline__ unsigned long long rt() { return __builtin_amdgcn_s_memrealtime(); }
__device__ __forceinline__ unsigned f2bf(float f) { unsigned u = __builtin_bit_cast(unsigned, f); return (u + 0x7fffu + ((u >> 16) & 1u)) >> 16; }
__device__ __forceinline__ unsigned pk2(float lo, float hi) { return f2bf(lo) | (f2bf(hi) << 16); }

#define XB_TMO      128
#define XB_XCNT(j)  (256  + 64 * (j))
#define XB_XSUB(j)  (1280 + 64 * (j))
#define XB_XGEN(j)  (2304 + 64 * (j))
#define XB_TOP      3328
#define XB_TOPGEN   3392
#define XCD_BAR_WORDS 3456
#define XB_SPIN_CAP (1u << 18)

__device__ __forceinline__ unsigned xb_ld(unsigned* p)              { return __hip_atomic_load(p, __ATOMIC_RELAXED, __HIP_MEMORY_SCOPE_AGENT); }
__device__ __forceinline__ unsigned xb_add(unsigned* p, unsigned v) { return __hip_atomic_fetch_add(p, v, __ATOMIC_RELAXED, __HIP_MEMORY_SCOPE_AGENT); }
__device__ __forceinline__ unsigned xb_xcc_id() { return (unsigned)__builtin_amdgcn_s_getreg((3 << 11) | 20) & 0xFu; }
#define XB_SPIN(cond, bar) do { unsigned _sp = 0; while (cond) { __builtin_amdgcn_s_sleep(1); \
    if ((++_sp & 255u) == 0u) { if (xb_ld(&(bar)[XB_TMO])) break; if (_sp > XB_SPIN_CAP) { atomicAdd(&(bar)[XB_TMO], 1u); break; } } } } while (0)

struct XcdBarrier {
    unsigned* bar; unsigned x;
    volatile LAS unsigned* st;
};

__device__ __forceinline__ XcdBarrier xcd_barrier_post(unsigned* bar, volatile LAS unsigned* st) {
    XcdBarrier b; b.bar = bar; b.x = xb_xcc_id(); b.st = st;
    if (threadIdx.x == 0) (void)xb_add(&bar[XB_XCNT(b.x)], 1u);
    return b;
}
__device__ __forceinline__ void xcd_barrier_complete(unsigned* bar, unsigned x, unsigned& nloc, unsigned& nx) {
    const unsigned G = gridDim.x * gridDim.y * gridDim.z;
    unsigned sum, cnt, mine, sp = 0u;
    for (;;) {
        sum = 0u; cnt = 0u; mine = 0u;
#pragma unroll
        for (unsigned j = 0; j < 16; ++j) { const unsigned c = xb_ld(&bar[XB_XCNT(j)]); sum += c; cnt += (c > 0u) ? 1u : 0u; mine = (j == x) ? c : mine; }
        if (sum == G) break;
        __builtin_amdgcn_s_sleep(1);
        if ((++sp & 255u) == 0u) { if (xb_ld(&bar[XB_TMO])) break; if (sp > XB_SPIN_CAP) { atomicAdd(&bar[XB_TMO], 1u); break; } }
    }
    nloc = mine > 0u ? mine : 1u; nx = cnt > 0u ? cnt : 1u;
}

__device__ __forceinline__ void xcd_barrier(const XcdBarrier& b) {
    asm volatile("s_waitcnt vmcnt(0)" ::: "memory");
    __syncthreads();
    if (threadIdx.x == 0) {
        unsigned* bar = b.bar;
        __builtin_amdgcn_s_waitcnt(0);
        unsigned nloc = b.st[0], nx = b.st[1];
        if (nloc == 0u) { xcd_barrier_complete(bar, b.x, nloc, nx); b.st[0] = nloc; b.st[1] = nx; }
        const unsigned old = xb_add(&bar[XB_XSUB(b.x)], 1u);
        const unsigned gen = old / nloc;
        if (old + 1u == (gen + 1u) * nloc) {
            __builtin_amdgcn_fence(__ATOMIC_RELEASE, "agent");
            asm volatile("s_waitcnt vmcnt(0)" ::: "memory");
            const unsigned og = xb_add(&bar[XB_TOP], 1u);
            const unsigned tg = og / nx;
            if (og + 1u == (tg + 1u) * nx) xb_add(&bar[XB_TOPGEN], 1u);
            else XB_SPIN(xb_ld(&bar[XB_TOPGEN]) == tg, bar);
            __builtin_amdgcn_fence(__ATOMIC_ACQUIRE, "agent");
            xb_add(&bar[XB_XGEN(b.x)], 1u);
            asm volatile("s_waitcnt vmcnt(0)" ::: "memory");
        } else {
            XB_SPIN(xb_ld(&bar[XB_XGEN(b.x)]) == gen, bar);
            __builtin_amdgcn_fence(__ATOMIC_ACQUIRE, "agent");
            asm volatile("s_waitcnt vmcnt(0)" ::: "memory");
        }
    }
    __syncthreads();
}

struct Frame {
    LAS unsigned char* lds;
    volatile LAS unsigned* MISC;
    gu32* ctl;
    int tid, lane, wave;
    int vcu, G;
    const float *x, *c, *w_ada, *b_ada, *g_mix, *w_in, *b_ig, *b_fg, *g_head, *w_pool, *pool_scale, *w_out, *g_ffn, *w_ff1, *w_ff2, *g_final;
    float* out;
    float* mod; float* GT; bf16 *HFb, *HBb;
    bf16 *WIN, *WOUT, *W1, *W2, *HBUF, *QB, *KB, *VB, *OB, *UB, *AB;
};

__device__ __forceinline__ float wave_sum(float v) {
#pragma unroll
    for (int o = 1; o < 64; o <<= 1) v += __shfl_xor(v, o);
    return v;
}
__device__ __forceinline__ float bf2f(unsigned short h) { return __builtin_bit_cast(float, (unsigned)h << 16); }
__device__ __forceinline__ float bflo(unsigned w) { return __builtin_bit_cast(float, w << 16); }
__device__ __forceinline__ float bfhi(unsigned w) { return __builtin_bit_cast(float, w & 0xffff0000u); }
typedef float f32x2_t __attribute__((ext_vector_type(2))); typedef __bf16 bf16x2_t __attribute__((ext_vector_type(2)));
__device__ __forceinline__ unsigned cvtpk(float lo, float hi) { f32x2_t v = {lo, hi}; bf16x2_t b = __builtin_convertvector(v, bf16x2_t); return __builtin_bit_cast(unsigned, b); }

__device__ __forceinline__ void p0_transpose_item(const float* W, int ldw, int c0, bf16* WT, int ldt, int r0, int k0, LAS float* scr, int lane) {
#pragma unroll 8
    for (int i = 0; i < 32; ++i) { const int kk = 2 * i + (lane >> 5); scr[kk * 33 + (lane & 31)] = W[(size_t)(k0 + kk) * ldw + c0 + (lane & 31)]; }
    LDS_WAIT(); asm volatile("" ::: "memory");
    const int c = lane & 7;
#pragma unroll
    for (int j = 0; j < 4; ++j) { const int n = (lane >> 3) + 8 * j; const LAS float* s = scr + (8 * c) * 33 + n;
        v4u o; o.x = pk2(s[0 * 33], s[1 * 33]); o.y = pk2(s[2 * 33], s[3 * 33]); o.z = pk2(s[4 * 33], s[5 * 33]); o.w = pk2(s[6 * 33], s[7 * 33]);
        *(GAS v4u*)(WT + (size_t)(r0 + n) * ldt + k0 + 8 * c) = o; }
    LDS_WAIT(); asm volatile("" ::: "memory");
}

__device__ __forceinline__ void p0_prologue(Frame& F) {
    const int lane = F.lane, wave = F.wave, tid = F.tid;
    if (F.vcu < 192) {
        LAS float* cact = (LAS float*)(F.lds + RING_OFF);
        LAS float* red = (LAS float*)(F.lds + RING_OFF + 32768);
        for (int i = tid; i < BATCH * D; i += NWAVES * 64) { const float v = F.c[i]; cact[i] = v * pg8::sigmoidf_fast(v); }
        __syncthreads();
        const int it = F.vcu, cl = lane & 7, kr = lane >> 3;
        f32x4 acc[8];
#pragma unroll
        for (int b = 0; b < 8; ++b) acc[b] = (f32x4){0.f, 0.f, 0.f, 0.f};
#pragma unroll 4
        for (int i = 0; i < 16; ++i) { const int k = 128 * wave + 8 * i + kr;
            const f32x4 wv = *(const GAS f32x4*)(F.w_ada + (size_t)k * 6144 + 32 * it + 4 * cl);
#pragma unroll
            for (int b = 0; b < 8; ++b) acc[b] += cact[b * D + k] * wv; }
#pragma unroll
        for (int b = 0; b < 8; ++b)
#pragma unroll
            for (int q = 0; q < 4; ++q) { float v = acc[b][q]; v += __shfl_xor(v, 8); v += __shfl_xor(v, 16); v += __shfl_xor(v, 32); acc[b][q] = v; }
        if (kr == 0) {
#pragma unroll
            for (int b = 0; b < 8; ++b) *(LAS f32x4*)(red + (wave * 8 + b) * 32 + 4 * cl) = acc[b]; }
        __syncthreads();
        if (tid < 256) { const int b = tid >> 5, col = tid & 31; float s = 0.f;
#pragma unroll
            for (int w = 0; w < 8; ++w) s += red[(w * 8 + b) * 32 + col];
            F.mod[b * 6144 + 32 * it + col] = s + F.b_ada[32 * it + col]; }
        __syncthreads();
    }
    LAS float* scr = (LAS float*)(F.lds + RING_OFF + wave * 16384);
    const int gw = F.vcu * NWAVES + wave, NGW = F.G * NWAVES;
    constexpr int I_A = 16 * 64, I_B = 16 * 16, I_C = 8 * 32, I_D = 16 * 128, I_E = 64 * 32;
    constexpr int NITEMS = I_A + I_B + I_C + I_D + I_E;
    for (int it = gw; it < NITEMS; it += NGW) {
        int r = it;
        if (r < I_A) { const int kb = r / 64, nb = r % 64; p0_transpose_item(F.w_in, DIN, 32 * nb, F.WIN, D, 32 * nb, 64 * kb, scr, lane); continue; } r -= I_A;
        if (r < I_B) { const int kb = r / 16, nb = r % 16; p0_transpose_item(F.w_in, DIN, 2064 + 32 * nb, F.WIN, D, 2048 + 32 * nb, 64 * kb, scr, lane); continue; } r -= I_B;
        if (r < I_C) { const int kb = r / 32, nb = r % 32; p0_transpose_item(F.w_out, D, 32 * nb, F.WOUT, D, 32 * nb, 64 * kb, scr, lane); continue; } r -= I_C;
        if (r < I_D) { const int kb = r / 128, nb = r % 128; p0_transpose_item(F.w_ff1, FF, 32 * nb, F.W1, D, 32 * nb, 64 * kb, scr, lane); continue; } r -= I_D;
        { const int kb = r / 32, nb = r % 32; p0_transpose_item(F.w_ff2, D, 32 * nb, F.W2, FF, 32 * nb, 64 * kb, scr, lane); }
    }
    for (int it = gw; it < 2048; it += NGW) {
        const int g = it >> 9, nblk = (it >> 5) & 15, cblk = it & 31, n = 64 * nblk + lane, c0 = 4 * cblk;
        LAS f32x4* wps = (LAS f32x4*)scr;
        const GAS f32x4* wsrc = (const GAS f32x4*)(F.w_pool + (size_t)(g * 128 + c0) * 128);
        wps[lane] = wsrc[lane]; wps[64 + lane] = wsrc[64 + lane];
        LDS_WAIT(); asm volatile("" ::: "memory");
        float acc[4] = {0.f, 0.f, 0.f, 0.f};
        const float* wo_p = F.w_out + (size_t)(512 + g * 128) * D + n; const float* ps_p = F.pool_scale + g * 128;
#pragma unroll 2
        for (int e8 = 0; e8 < 16; ++e8) { float wo[8];
#pragma unroll
            for (int q = 0; q < 8; ++q) wo[q] = wo_p[(size_t)(8 * e8 + q) * D] * ps_p[8 * e8 + q];
#pragma unroll
            for (int cc = 0; cc < 4; ++cc) { const f32x4 p0 = wps[cc * 32 + 2 * e8], p1 = wps[cc * 32 + 2 * e8 + 1];
                acc[cc] += (p0.x * wo[0] + p0.y * wo[1]) + (p0.z * wo[2] + p0.w * wo[3]) + (p1.x * wo[4] + p1.y * wo[5]) + (p1.z * wo[6] + p1.w * wo[7]); } }
        *(GAS unsigned long long*)(F.WOUT + (size_t)n * D + 512 + g * 128 + c0) = (unsigned long long)pk2(acc[0], acc[1]) | ((unsigned long long)pk2(acc[2], acc[3]) << 32);
        LDS_WAIT(); asm volatile("" ::: "memory");
    }
}

template <bool GATES>
__device__ __forceinline__ void rows_norm_mod(Frame& F, const float* X, const float* gvec, int sh_off, int sc_off, bf16* Hout) {
    const int lane = F.lane;
    LAS f32x4* WGl = (LAS f32x4*)(F.lds + RING_OFF);
    if (GATES) {
        for (int idx = F.tid; idx < 4096; idx += NWAVES * 64) { const int l = idx & 63, t = idx >> 6, cq = t & 3, i = (t >> 2) & 3, j = t >> 4;
            WGl[idx] = *(const GAS f32x4*)(F.w_in + (size_t)(4 * l + 256 * j + i) * DIN + 2048 + 4 * cq); }
        __syncthreads();
    }
    const int NGW = F.G * NWAVES;
    for (int gw = F.vcu * NWAVES + F.wave; gw < M / 16; gw += NGW) {
        const int m0 = gw * 16, b = m0 / SEQ;
        f32x4 gs[4], sh[4];
#pragma unroll
        for (int j = 0; j < 4; ++j) { const int k = 4 * lane + 256 * j;
            const f32x4 g = *(const GAS f32x4*)(gvec + k), sc = *(const GAS f32x4*)(F.mod + b * 6144 + sc_off + k);
            gs[j] = g * (1.0f + sc); sh[j] = *(const GAS f32x4*)(F.mod + b * 6144 + sh_off + k); }
#pragma unroll 1
        for (int rg = 0; rg < 4; ++rg) {
            f32x4 xv[4][4]; float rstd[4];
#pragma unroll
            for (int r = 0; r < 4; ++r) { const GAS f32x4* xr = (const GAS f32x4*)(X + (size_t)(m0 + rg * 4 + r) * D) + lane;
#pragma unroll
                for (int j = 0; j < 4; ++j) xv[r][j] = xr[64 * j]; }
#pragma unroll
            for (int r = 0; r < 4; ++r) { float s = 0.f;
#pragma unroll
                for (int j = 0; j < 4; ++j) s += (xv[r][j].x * xv[r][j].x + xv[r][j].y * xv[r][j].y) + (xv[r][j].z * xv[r][j].z + xv[r][j].w * xv[r][j].w);
                rstd[r] = 1.0f / sqrtf(wave_sum(s) * (1.0f / D) + EPS); }
#pragma unroll
            for (int r = 0; r < 4; ++r) { GAS unsigned long long* o8 = (GAS unsigned long long*)(Hout + (size_t)(m0 + rg * 4 + r) * D) + lane;
#pragma unroll
                for (int j = 0; j < 4; ++j) { xv[r][j] = xv[r][j] * rstd[r] * gs[j] + sh[j];
                    o8[64 * j] = (unsigned long long)pk2(xv[r][j].x, xv[r][j].y) | ((unsigned long long)pk2(xv[r][j].z, xv[r][j].w) << 32); } }
            if (GATES) {
                float v[64];
#pragma unroll
                for (int q = 0; q < 64; ++q) v[q] = 0.f;
#pragma unroll
                for (int j = 0; j < 4; ++j)
#pragma unroll
                    for (int i = 0; i < 4; ++i)
#pragma unroll
                        for (int cq = 0; cq < 4; ++cq) { const f32x4 wv = WGl[((j * 4 + i) * 4 + cq) * 64 + lane];
#pragma unroll
                            for (int r = 0; r < 4; ++r) { const float hv = xv[r][j][i];
                                v[r * 16 + 4 * cq + 0] += hv * wv.x; v[r * 16 + 4 * cq + 1] += hv * wv.y; v[r * 16 + 4 * cq + 2] += hv * wv.z; v[r * 16 + 4 * cq + 3] += hv * wv.w; }
                            if (cq == 3) asm volatile("" ::: "memory"); }
#pragma unroll
                for (int half = 32; half >= 1; half >>= 1) { const bool up = (lane & half) != 0;
#pragma unroll
                    for (int i = 0; i < half; ++i) { const float keep = up ? v[i + half] : v[i], send = up ? v[i] : v[i + half]; v[i] = keep + __shfl_xor(send, half); } }
                const int r = lane >> 4, cidx = lane & 15, dir = cidx >> 3, gate = (cidx >> 2) & 1, head = cidx & 3;
                float val = v[0];
                if (gate == 0) val += F.b_ig[dir * NH + head];
                else { const float z = val + F.b_fg[dir * NH + head]; val = fminf(z, 0.f) - log1pf(__expf(-fabsf(z))); }
                F.GT[(size_t)cidx * M + m0 + rg * 4 + r] = val;
            }
        }
    }
}

#ifdef OLD_SCAN
namespace scan {
constexpr int KP = 136;
constexpr int OFF_K = 0, OFF_KT = 34816, OFF_VT = 69632, OFF_CT = 82688, OFF_TAB = 95744;
constexpr int TAB_BYTES = 5 * 128 * 4;
static_assert(OFF_TAB + 8 * TAB_BYTES <= RING_BYTES, "scan LDS map");
typedef float f32x2 __attribute__((ext_vector_type(2)));
typedef unsigned u32x2 __attribute__((ext_vector_type(2)));

__device__ __forceinline__ void scan_item(Frame& F, int item) {
    const int tid = F.tid, lane = F.lane, wave = F.wave, l15 = lane & 15, kq = lane >> 4;
    const int j = item & 3, dir = (item >> 2) & 1, h = (item >> 3) & 3, b = item >> 5;
    LAS unsigned char* L = F.lds + RING_OFF;
    LAS bf16* Kl = (LAS bf16*)(L + OFF_K); LAS bf16* Ktl = (LAS bf16*)(L + OFF_KT); LAS bf16* Vtl = (LAS bf16*)(L + OFF_VT); LAS bf16* Ctl = (LAS bf16*)(L + OFF_CT);
    LAS float* tab = (LAS float*)(L + OFF_TAB + wave * TAB_BYTES);
    for (int i = tid; i < 16 * KP; i += NWAVES * 64) Vtl[32 * KP + i] = (i < KP) ? (bf16)0x3F80 : (bf16)0;
    for (int i = tid; i < 48 * KP; i += NWAVES * 64) Ctl[i] = 0;
    f32x4 Cacc[3];
#pragma unroll
    for (int e = 0; e < 3; ++e) Cacc[e] = (f32x4){0.f, 0.f, 0.f, 0.f};
    float mcar = 0.f;
    const float* gli = F.GT + (size_t)(dir * 8 + 0 + h) * M + (size_t)b * SEQ;
    const float* glf = F.GT + (size_t)(dir * 8 + 4 + h) * M + (size_t)b * SEQ;
    float* Hout = dir ? (float*)F.HBb : (float*)F.HFb;
    const size_t rowb = (size_t)b * SEQ;
#pragma unroll 1
    for (int cc = 0; cc < NCHUNK; ++cc) {
        const int ci = dir ? (NCHUNK - 1 - cc) : cc, t0 = ci * CHUNK;
#define ROWOF(i) (t0 + (dir ? (CHUNK - 1 - (i)) : (i)))
        { const int i = tid >> 2, qd = tid & 3; const size_t grow = rowb + ROWOF(i);
          const GAS v4u* src = (const GAS v4u*)(F.KB + grow * DML + h * DH + qd * 32);
          v4u kv[4];
#pragma unroll
          for (int c = 0; c < 4; ++c) kv[c] = src[c];
          const GAS v4u* vsrc = (const GAS v4u*)(F.VB + grow * DML + h * DH + j * 32 + qd * 8);
          const v4u vv = vsrc[0];
#pragma unroll
          for (int c = 0; c < 4; ++c) { *(LAS v4u*)(Kl + i * KP + qd * 32 + c * 8) = kv[c];
#pragma unroll
              for (int q = 0; q < 4; ++q) { const unsigned w = kv[c][q]; const int d = qd * 32 + c * 8 + 2 * q;
                  Ktl[d * KP + i] = (bf16)(w & 0xffffu); Ktl[(d + 1) * KP + i] = (bf16)(w >> 16); } }
#pragma unroll
          for (int q = 0; q < 4; ++q) { const unsigned w = vv[q]; const int e = qd * 8 + 2 * q;
              Vtl[e * KP + i] = (bf16)(w & 0xffffu); Vtl[(e + 1) * KP + i] = (bf16)(w >> 16); }
        }
        bf16x8 Qf[4];
        { const size_t grow = rowb + ROWOF(16 * wave + l15); const GAS bf16x8* qs = (const GAS bf16x8*)(F.QB + grow * DML + h * DH + 8 * kq);
#pragma unroll
          for (int s = 0; s < 4; ++s) Qf[s] = qs[4 * s]; }
        float decay;
        { float li0, li1, lf0, lf1;
          if (dir) { const f32x2 a = *(const GAS f32x2*)(gli + t0 + 126 - 2 * lane), c = *(const GAS f32x2*)(glf + t0 + 126 - 2 * lane); li0 = a.y; li1 = a.x; lf0 = c.y; lf1 = c.x; }
          else     { const f32x2 a = *(const GAS f32x2*)(gli + t0 + 2 * lane), c = *(const GAS f32x2*)(glf + t0 + 2 * lane); li0 = a.x; li1 = a.y; lf0 = c.x; lf1 = c.y; }
          const float p = lf0 + lf1; float inc = p;
#pragma unroll
          for (int o = 1; o < 64; o <<= 1) { const float t = __shfl_up(inc, o); if (lane >= o) inc += t; }
          const float b0 = (inc - p) + lf0, b1 = b0 + lf1;
          const float a0 = li0 - b0, a1 = li1 - b1;
          float mx = fmaxf(a0, a1);
#pragma unroll
          for (int o = 1; o < 64; o <<= 1) { const float t = __shfl_up(mx, o); if (lane >= o) mx = fmaxf(mx, t); }
          float ex = __shfl_up(mx, 1); if (lane == 0) ex = -INFINITY;
          const float cm0 = fmaxf(ex, a0), cm1 = fmaxf(cm0, a1);
          const float u0 = fmaxf(mcar, cm0), u1 = fmaxf(mcar, cm1);
          const float ulast = __shfl(u1, 63), blast = __shfl(b1, 63);
          *(LAS f32x2*)(tab + 0 * 128 + 2 * lane) = (f32x2){a0 * LOG2E, a1 * LOG2E};
          *(LAS f32x2*)(tab + 1 * 128 + 2 * lane) = (f32x2){u0 * LOG2E, u1 * LOG2E};
          *(LAS f32x2*)(tab + 2 * 128 + 2 * lane) = (f32x2){__expf(mcar - u0), __expf(mcar - u1)};
          *(LAS f32x2*)(tab + 3 * 128 + 2 * lane) = (f32x2){__expf(-(b0 + u0)), __expf(-(b1 + u1))};
          *(LAS f32x2*)(tab + 4 * 128 + 2 * lane) = (f32x2){__expf(a0 - ulast), __expf(a1 - ulast)};
          decay = __expf(mcar - ulast); mcar = blast + ulast; }
        __syncthreads();
        f32x4 ST[8];
#pragma unroll
        for (int sg = 0; sg < 8; ++sg) { f32x4 a = (f32x4){0.f, 0.f, 0.f, 0.f};
#pragma unroll
            for (int s = 0; s < 4; ++s) { const bf16x8 kf = *(const LAS bf16x8*)(Kl + (16 * sg + l15) * KP + 32 * s + 8 * kq);
                a = __builtin_amdgcn_mfma_f32_16x16x32_bf16(kf, Qf[s], a, 0, 0, 0); }
            ST[sg] = a; }
        const int tl = 16 * wave + l15; const float ut = tab[1 * 128 + tl];
        v4u Pk[4];
#pragma unroll
        for (int sg = 0; sg < 8; ++sg) { const f32x4 as = *(const LAS f32x4*)(tab + 0 * 128 + 16 * sg + 4 * kq); float pv[4];
#pragma unroll
            for (int r = 0; r < 4; ++r) { const int s = 16 * sg + 4 * kq + r; const float w = __builtin_amdgcn_exp2f(fminf(as[r] - ut, 0.f)); pv[r] = (s <= tl) ? ST[sg][r] * w : 0.f; }
            Pk[sg >> 1][(sg & 1) * 2 + 0] = pk2(pv[0], pv[1]); Pk[sg >> 1][(sg & 1) * 2 + 1] = pk2(pv[2], pv[3]); }
        f32x4 Oa[3], C2[3];
#pragma unroll
        for (int e = 0; e < 3; ++e) { f32x4 o = (f32x4){0.f, 0.f, 0.f, 0.f}, c2 = (f32x4){0.f, 0.f, 0.f, 0.f};
#pragma unroll
            for (int i = 0; i < 4; ++i) { const LAS bf16* vr = Vtl + (16 * e + l15) * KP + 32 * i + 4 * kq;
                const u32x2 lo = *(const LAS u32x2*)(vr), hi = *(const LAS u32x2*)(vr + 16);
                const v4u vb = (v4u){lo.x, lo.y, hi.x, hi.y};
                o = __builtin_amdgcn_mfma_f32_16x16x32_bf16(__builtin_bit_cast(bf16x8, Pk[i]), __builtin_bit_cast(bf16x8, vb), o, 0, 0, 0);
                const bf16x8 cf = *(const LAS bf16x8*)(Ctl + (16 * e + l15) * KP + 32 * i + 8 * kq);
                c2 = __builtin_amdgcn_mfma_f32_16x16x32_bf16(Qf[i], cf, c2, 0, 0, 0); }
            Oa[e] = o; C2[e] = c2; }
        { const f32x4 ai = *(const LAS f32x4*)(tab + 2 * 128 + 16 * wave + 4 * kq), fl = *(const LAS f32x4*)(tab + 3 * 128 + 16 * wave + 4 * kq);
          f32x4 tot[3];
#pragma unroll
          for (int e = 0; e < 3; ++e) tot[e] = Oa[e] + ai * C2[e];
#pragma unroll
          for (int r = 0; r < 4; ++r) { const float den = __shfl(tot[2][r], lane & 48); const float inv = 1.0f / fmaxf(fabsf(den), fl[r]);
              const size_t grow = rowb + ROWOF(16 * wave + 4 * kq + r); float* hp = Hout + grow * DML + h * DH + j * 32 + l15;
              hp[0] = tot[0][r] * inv; hp[16] = tot[1][r] * inv; } }
        __syncthreads();
#pragma unroll
        for (int e = 0; e < 3; ++e) Cacc[e] = Cacc[e] * decay;
#pragma unroll
        for (int i = 0; i < 4; ++i) { const v4u kraw = *(const LAS v4u*)(Ktl + (16 * wave + l15) * KP + 32 * i + 8 * kq);
            const f32x4 w0 = *(const LAS f32x4*)(tab + 4 * 128 + 32 * i + 8 * kq), w1 = *(const LAS f32x4*)(tab + 4 * 128 + 32 * i + 8 * kq + 4);
            v4u ks; ks.x = pk2(bflo(kraw.x) * w0.x, bfhi(kraw.x) * w0.y); ks.y = pk2(bflo(kraw.y) * w0.z, bfhi(kraw.y) * w0.w);
            ks.z = pk2(bflo(kraw.z) * w1.x, bfhi(kraw.z) * w1.y); ks.w = pk2(bflo(kraw.w) * w1.z, bfhi(kraw.w) * w1.w);
#pragma unroll
            for (int e = 0; e < 3; ++e) { const bf16x8 vf = *(const LAS bf16x8*)(Vtl + (16 * e + l15) * KP + 32 * i + 8 * kq);
                Cacc[e] = __builtin_amdgcn_mfma_f32_16x16x32_bf16(__builtin_bit_cast(bf16x8, ks), vf, Cacc[e], 0, 0, 0); } }
#pragma unroll
        for (int e = 0; e < 3; ++e) { u32x2 w; w.x = pk2(Cacc[e][0], Cacc[e][1]); w.y = pk2(Cacc[e][2], Cacc[e][3]);
            *(LAS u32x2*)(Ctl + (16 * e + l15) * KP + 16 * wave + 4 * kq) = w; }
        __syncthreads();
#undef ROWOF
    }
}
}

#else
namespace scan {
constexpr int KPI = 144, VPI = 48, CPI = 136;
constexpr int SZ_K = 128 * KPI * 2, SZ_V = 128 * VPI * 2, SZ_C = 48 * CPI * 2, SZ_T = 5 * 128 * 4;
constexpr int OFF_KI = 0, OFF_VI = 2 * SZ_K, OFF_CT = OFF_VI + 2 * SZ_V, OFF_TB = OFF_CT + 2 * SZ_C;
static_assert(OFF_TB + 2 * SZ_T <= RING_BYTES, "scan LDS map");
typedef float f32x2 __attribute__((ext_vector_type(2)));
typedef unsigned u32x2 __attribute__((ext_vector_type(2)));
typedef short s16x4 __attribute__((ext_vector_type(4)));
typedef short v4i16_t __attribute__((ext_vector_type(4)));
__device__ __forceinline__ s16x4 trd(const LAS bf16* p) { return __builtin_bit_cast(s16x4, __builtin_amdgcn_ds_read_tr16_b64_v4i16((LAS v4i16_t*)p)); }

__device__ __forceinline__ void scan_item(Frame& F, int item) {
    const int tid = F.tid, lane = F.lane, wave = F.wave, l15 = lane & 15, kq = lane >> 4;
    const int j = item & 3, dir = (item >> 2) & 1, h = (item >> 3) & 3, b = item >> 5;
    LAS unsigned char* L = F.lds + RING_OFF;
#define KI(bf) ((LAS bf16*)(L + OFF_KI + (bf) * SZ_K))
#define VI(bf) ((LAS bf16*)(L + OFF_VI + (bf) * SZ_V))
#define CT(bf) ((LAS bf16*)(L + OFF_CT + (bf) * SZ_C))
#define TB(bf) ((LAS float*)(L + OFF_TB + (bf) * SZ_T))
    const float* gli = F.GT + (size_t)(dir * 8 + 0 + h) * M + (size_t)b * SEQ;
    const float* glf = F.GT + (size_t)(dir * 8 + 4 + h) * M + (size_t)b * SEQ;
    bf16* Hout = dir ? F.HBb : F.HFb;
    const size_t rowb = (size_t)b * SEQ;
    const int krow = tid >> 4, kch = tid & 15, vrow = tid >> 2, vch = tid & 3;
    const int tq = l15 >> 2, tp = l15 & 3;
    const int tt = (wave < 4) ? wave : 11 - wave;
    const int vtr_off = (4 * kq + tq) * VPI + 4 * tp, ktr_off = (4 * kq + tq) * KPI + 16 * wave + 4 * tp;
#define T0(cc_) ((dir ? (NCHUNK - 1 - (cc_)) : (cc_)) * CHUNK)
#define ROWG(cc_, i) (rowb + T0(cc_) + (dir ? (CHUNK - 1 - (i)) : (i)))
    v4u Kreg[4], Vreg; bf16x8 Qn[4]; f32x4 gli_a, gli_b, glf_a, glf_b;
#define ISSUE(cc_) do { \
        _Pragma("unroll") for (int r = 0; r < 4; ++r) Kreg[r] = *(const GAS v4u*)(F.KB + ROWG(cc_, krow + 32 * r) * DML + h * DH + 8 * kch); \
        Vreg = *(const GAS v4u*)(F.VB + ROWG(cc_, vrow) * DML + h * DH + 32 * j + 8 * vch); \
        { const GAS bf16x8* qs = (const GAS bf16x8*)(F.QB + ROWG(cc_, 16 * tt + l15) * DML + h * DH + 8 * kq); \
          _Pragma("unroll") for (int s = 0; s < 4; ++s) Qn[s] = qs[4 * s]; } \
        { const int go_ = T0(cc_) + (dir ? 120 - 8 * l15 : 8 * l15); \
          gli_a = *(const GAS f32x4*)(gli + go_); gli_b = *(const GAS f32x4*)(gli + go_ + 4); glf_a = *(const GAS f32x4*)(glf + go_); glf_b = *(const GAS f32x4*)(glf + go_ + 4); } \
    } while (0)
#define COMMIT(bf) do { \
        _Pragma("unroll") for (int r = 0; r < 4; ++r) *(LAS v4u*)(KI(bf) + (krow + 32 * r) * KPI + 8 * kch) = Kreg[r]; \
        *(LAS v4u*)(VI(bf) + vrow * VPI + 8 * vch) = Vreg; } while (0)
    float mcar = 0.f, decay = 1.f;
#define DPP_SHR(n) (0x110 + (n))
#define DPPF(oldv, srcv, ctrl) __builtin_bit_cast(float, __builtin_amdgcn_update_dpp(__builtin_bit_cast(int, (float)(oldv)), __builtin_bit_cast(int, (float)(srcv)), (ctrl), 0xF, 0xF, false))
#define TABLES(bf) do { \
        float lf_[8], li_[8]; \
        _Pragma("unroll") for (int k = 0; k < 4; ++k) { lf_[k] = dir ? glf_b[3 - k] : glf_a[k]; lf_[4 + k] = dir ? glf_a[3 - k] : glf_b[k]; li_[k] = dir ? gli_b[3 - k] : gli_a[k]; li_[4 + k] = dir ? gli_a[3 - k] : gli_b[k]; } \
        float b_[8]; b_[0] = lf_[0]; \
        _Pragma("unroll") for (int k = 1; k < 8; ++k) b_[k] = b_[k - 1] + lf_[k]; \
        float inc_ = b_[7]; \
        inc_ += DPPF(0.f, inc_, DPP_SHR(1)); inc_ += DPPF(0.f, inc_, DPP_SHR(2)); inc_ += DPPF(0.f, inc_, DPP_SHR(4)); inc_ += DPPF(0.f, inc_, DPP_SHR(8)); \
        const float exc_ = inc_ - b_[7]; \
        float a_[8], c_[8]; \
        _Pragma("unroll") for (int k = 0; k < 8; ++k) { b_[k] += exc_; a_[k] = li_[k] - b_[k]; } \
        c_[0] = a_[0]; \
        _Pragma("unroll") for (int k = 1; k < 8; ++k) c_[k] = fmaxf(c_[k - 1], a_[k]); \
        float mx_ = c_[7]; \
        mx_ = fmaxf(mx_, DPPF(-INFINITY, mx_, DPP_SHR(1))); mx_ = fmaxf(mx_, DPPF(-INFINITY, mx_, DPP_SHR(2))); mx_ = fmaxf(mx_, DPPF(-INFINITY, mx_, DPP_SHR(4))); mx_ = fmaxf(mx_, DPPF(-INFINITY, mx_, DPP_SHR(8))); \
        const float ex_ = fmaxf(mcar, DPPF(-INFINITY, mx_, DPP_SHR(1))); \
        float u_[8]; \
        _Pragma("unroll") for (int k = 0; k < 8; ++k) u_[k] = fmaxf(ex_, c_[k]); \
        const float ulast = __builtin_bit_cast(float, __builtin_amdgcn_readlane(__builtin_bit_cast(int, u_[7]), 15)), blast = __builtin_bit_cast(float, __builtin_amdgcn_readlane(__builtin_bit_cast(int, b_[7]), 15)); \
        const int row_ = lane >> 4; const float c1_ = (row_ < 2) ? 1.f : 0.f, c2_ = (row_ == 2) ? 1.f : 0.f, c3_ = (row_ == 3) ? 1.f : 0.f; const bool odd_ = (row_ & 1) != 0; \
        float o_[8], p_[8]; \
        _Pragma("unroll") for (int k = 0; k < 8; ++k) { const float arg_ = c1_ * (mcar - u_[k]) + (c3_ * (a_[k] - ulast) - c2_ * (b_[k] + u_[k])); \
            o_[k] = __builtin_amdgcn_exp2f(arg_ * LOG2E); p_[k] = (odd_ ? u_[k] : a_[k]) * LOG2E; } \
        LAS float* tb_ = TB(bf); LAS float* dst_ = tb_ + ((row_ < 2) ? 2 : (row_ + 1)) * 128 + 8 * l15; LAS float* dst2_ = tb_ + (odd_ ? 128 : 0) + 8 * l15; \
        *(LAS f32x4*)(dst_) = (f32x4){o_[0], o_[1], o_[2], o_[3]}; *(LAS f32x4*)(dst_ + 4) = (f32x4){o_[4], o_[5], o_[6], o_[7]}; \
        *(LAS f32x4*)(dst2_) = (f32x4){p_[0], p_[1], p_[2], p_[3]}; *(LAS f32x4*)(dst2_ + 4) = (f32x4){p_[4], p_[5], p_[6], p_[7]}; \
        decay = __expf(mcar - ulast); mcar = blast + ulast; } while (0)
#ifdef SCAN_ZERO
    for (int i = tid; i < RING_BYTES / 16; i += NWAVES * 64) ((LAS v4u*)L)[i] = (v4u){0u, 0u, 0u, 0u};
    __syncthreads();
#endif
    for (int i = tid; i < 2 * 128 * 16; i += NWAVES * 64) { const int bf = i >> 11, r = (i >> 4) & 127, c = i & 15; VI(bf)[r * VPI + 32 + c] = (c == 0) ? (bf16)0x3F80 : (bf16)0; }
    for (int i = tid; i < 48 * CPI; i += NWAVES * 64) CT(0)[i] = 0;
    f32x4 Cacc[3];
#pragma unroll
    for (int e = 0; e < 3; ++e) Cacc[e] = (f32x4){0.f, 0.f, 0.f, 0.f};
    ISSUE(0); COMMIT(0); TABLES(0);
    bf16x8 Qf[4];
#pragma unroll
    for (int s = 0; s < 4; ++s) Qf[s] = Qn[s];
    __syncthreads();
#pragma unroll 1
    for (int cc = 0; cc < NCHUNK; ++cc) {
        const int cur = cc & 1, nxt = cur ^ 1;
#ifdef SCAN_NOPIPE
        if (cc > 0) { ISSUE(cc); COMMIT(cur); TABLES(cur);
#pragma unroll
            for (int s = 0; s < 4; ++s) Qf[s] = Qn[s];
            __syncthreads(); }
        const float decay_c = decay;
#else
        const float decay_c = decay;
        if (cc + 1 < NCHUNK) ISSUE(cc + 1);
#endif
        const LAS bf16* KIb = KI(cur); const LAS bf16* VIb = VI(cur); const LAS bf16* CTb = CT(cur); const LAS float* tb = TB(cur);
#define VLOAD(i) s16x4 vlo[3], vhi[3]; _Pragma("unroll") for (int e = 0; e < 3; ++e) { vlo[e] = trd(VIb + vtr_off + (32 * (i)) * VPI + 16 * e); vhi[e] = trd(VIb + vtr_off + (32 * (i) + 16) * VPI + 16 * e); }
#define VF(e, i) ((bf16x8){vlo[e][0], vlo[e][1], vlo[e][2], vlo[e][3], vhi[e][0], vhi[e][1], vhi[e][2], vhi[e][3]})
        f32x4 ST[8];
#pragma unroll
        for (int sg = 0; sg < 8; ++sg) { f32x4 a = (f32x4){0.f, 0.f, 0.f, 0.f};
            if (sg <= tt) {
#pragma unroll
                for (int s = 0; s < 4; ++s) { const bf16x8 kf = *(const LAS bf16x8*)(KIb + (16 * sg + l15) * KPI + 32 * s + 8 * kq);
                    a = __builtin_amdgcn_mfma_f32_16x16x32_bf16(kf, Qf[s], a, 0, 0, 0); } }
            ST[sg] = a; }
        const int tl = 16 * tt + l15; const float ut = tb[1 * 128 + tl];
        v4u Pk[4];
#pragma unroll
        for (int sg = 0; sg < 8; ++sg) { float pv[4] = {0.f, 0.f, 0.f, 0.f};
            if (sg <= tt) { const f32x4 as = *(const LAS f32x4*)(tb + 0 * 128 + 16 * sg + 4 * kq);
                if (sg < tt) {
#pragma unroll
                    for (int r = 0; r < 4; ++r) pv[r] = ST[sg][r] * __builtin_amdgcn_exp2f(as[r] - ut);
                } else {
#pragma unroll
                    for (int r = 0; r < 4; ++r) { const float w = __builtin_amdgcn_exp2f(fminf(as[r] - ut, 0.f)); pv[r] = (4 * kq + r <= l15) ? ST[sg][r] * w : 0.f; } } }
            Pk[sg >> 1][(sg & 1) * 2 + 0] = cvtpk(pv[0], pv[1]); Pk[sg >> 1][(sg & 1) * 2 + 1] = cvtpk(pv[2], pv[3]); }
        f32x4 Oa[3], C2[3];
#pragma unroll
        for (int e = 0; e < 3; ++e) { Oa[e] = (f32x4){0.f, 0.f, 0.f, 0.f}; C2[e] = (f32x4){0.f, 0.f, 0.f, 0.f}; }
#pragma unroll
        for (int i = 0; i < 4; ++i) {
            if (2 * i <= tt) { VLOAD(i)
#pragma unroll
                for (int e = 0; e < 3; ++e) Oa[e] = __builtin_amdgcn_mfma_f32_16x16x32_bf16(VF(e, i), __builtin_bit_cast(bf16x8, Pk[i]), Oa[e], 0, 0, 0); }
#pragma unroll
            for (int e = 0; e < 3; ++e) { const bf16x8 cf = *(const LAS bf16x8*)(CTb + (16 * e + l15) * CPI + 32 * i + 8 * kq);
                C2[e] = __builtin_amdgcn_mfma_f32_16x16x32_bf16(cf, Qf[i], C2[e], 0, 0, 0); } }
        { const float ai = tb[2 * 128 + tl], fl = tb[3 * 128 + tl];
          const float den = __shfl(Oa[2][0] + ai * C2[2][0], l15); const float inv = 1.0f / fmaxf(fabsf(den), fl);
#ifdef SCAN_F32_OUT
          float* hp = (float*)Hout + ROWG(cc, tl) * DML + h * DH + j * 32 + 4 * kq;
#pragma unroll
          for (int e = 0; e < 2; ++e) { const f32x4 tot = (Oa[e] + ai * C2[e]) * inv; *(GAS f32x4*)(hp + 16 * e) = tot; } }
#else
          bf16* hp = Hout + ROWG(cc, tl) * DML + h * DH + j * 32 + 4 * kq;
#pragma unroll
          for (int e = 0; e < 2; ++e) { const f32x4 tot = (Oa[e] + ai * C2[e]) * inv; u32x2 w; w.x = cvtpk(tot[0], tot[1]); w.y = cvtpk(tot[2], tot[3]);
              *(GAS u32x2*)(hp + 16 * e) = w; } }
#endif
#ifdef SCAN_XBAR
        __syncthreads();
#endif
#pragma unroll
        for (int e = 0; e < 3; ++e) Cacc[e] = Cacc[e] * decay_c;
#pragma unroll
        for (int i = 0; i < 4; ++i) { VLOAD(i) const s16x4 klo = trd(KIb + ktr_off + (32 * i) * KPI), khi = trd(KIb + ktr_off + (32 * i + 16) * KPI);
            const f32x4 w0 = *(const LAS f32x4*)(tb + 4 * 128 + 32 * i + 4 * kq), w1 = *(const LAS f32x4*)(tb + 4 * 128 + 32 * i + 16 + 4 * kq);
            v4u ks; ks.x = cvtpk(bf2f((unsigned short)klo[0]) * w0.x, bf2f((unsigned short)klo[1]) * w0.y); ks.y = cvtpk(bf2f((unsigned short)klo[2]) * w0.z, bf2f((unsigned short)klo[3]) * w0.w);
            ks.z = cvtpk(bf2f((unsigned short)khi[0]) * w1.x, bf2f((unsigned short)khi[1]) * w1.y); ks.w = cvtpk(bf2f((unsigned short)khi[2]) * w1.z, bf2f((unsigned short)khi[3]) * w1.w);
#pragma unroll
            for (int e = 0; e < 3; ++e) Cacc[e] = __builtin_amdgcn_mfma_f32_16x16x32_bf16(__builtin_bit_cast(bf16x8, ks), VF(e, i), Cacc[e], 0, 0, 0); }
        { LAS bf16* CTn = CT(nxt);
#pragma unroll
          for (int e = 0; e < 3; ++e) { u32x2 w; w.x = cvtpk(Cacc[e][0], Cacc[e][1]); w.y = cvtpk(Cacc[e][2], Cacc[e][3]);
              *(LAS u32x2*)(CTn + (16 * e + l15) * CPI + 16 * wave + 4 * kq) = w; } }
#ifdef SCAN_XBAR
        __syncthreads();
#endif
#ifndef SCAN_NOPIPE
        if (cc + 1 < NCHUNK) { COMMIT(nxt); TABLES(nxt);
#pragma unroll
            for (int s = 0; s < 4; ++s) Qf[s] = Qn[s]; }
#endif
        __syncthreads();
#undef VF
#undef VLOAD
    }
#undef KI
#undef VI
#undef CT
#undef TB
#undef T0
#undef ROWG
#undef ISSUE
#undef COMMIT
#undef TABLES
#undef DPP_SHR
#undef DPPF
}
}

#endif
__device__ __forceinline__ void up8(const v4u w, float (&o)[8]) { o[0] = bflo(w.x); o[1] = bfhi(w.x); o[2] = bflo(w.y); o[3] = bfhi(w.y); o[4] = bflo(w.z); o[5] = bfhi(w.z); o[6] = bflo(w.w); o[7] = bfhi(w.w); }
__device__ __forceinline__ void p4_combine(Frame& F) {
    const int lane = F.lane, NGW = F.G * NWAVES, grp = lane >> 4, hw = 1 << grp;
    f32x4 gh[2];
    gh[0] = *(const GAS f32x4*)(F.g_head + 8 * lane); gh[1] = *(const GAS f32x4*)(F.g_head + 8 * lane + 4);
    for (int gw = F.vcu * NWAVES + F.wave; gw < M / 16; gw += NGW) {
        const int m0 = gw * 16, t0 = m0 % SEQ; const size_t mb = (size_t)(m0 - t0);
        const bf16* Ub = F.UB + mb * DML + 8 * lane;
        float S[8];
#pragma unroll
        for (int q = 0; q < 8; ++q) S[q] = 0.f;
#pragma unroll
        for (int kb = 0; kb < 2; ++kb) { v4u uw[8];
#pragma unroll
          for (int k = 0; k < 8; ++k) { const int ts = t0 - hw + 8 * kb + k, tc = min(max(ts, 0), SEQ - 1); uw[k] = *(const GAS v4u*)(Ub + (size_t)tc * DML); }
#pragma unroll
          for (int k = 0; k < 8; ++k) { const int ts = t0 - hw + 8 * kb + k; const float ok = (8 * kb + k < 2 * hw && ts >= 0 && ts < SEQ) ? 1.f : 0.f; float x[8]; up8(uw[k], x);
#pragma unroll
              for (int q = 0; q < 8; ++q) S[q] += ok * x[q]; } }
#pragma unroll 1
        for (int rg = 0; rg < 8; ++rg) {
            v4u hfv[2], hbv[2], ov[2], uc[2], un[2], uo[2];
#pragma unroll
            for (int r = 0; r < 2; ++r) { const int t = t0 + rg * 2 + r; const size_t m = mb + t;
                hfv[r] = *(const GAS v4u*)(F.HFb + m * DML + 8 * lane); hbv[r] = *(const GAS v4u*)(F.HBb + m * DML + 8 * lane); ov[r] = *(const GAS v4u*)(F.OB + m * DML + 8 * lane);
                uc[r] = *(const GAS v4u*)(Ub + (size_t)t * DML); un[r] = *(const GAS v4u*)(Ub + (size_t)min(t + hw, SEQ - 1) * DML); uo[r] = *(const GAS v4u*)(Ub + (size_t)max(t - hw, 0) * DML); }
#pragma unroll
            for (int r = 0; r < 2; ++r) { const int t = t0 + rg * 2 + r; const size_t m = mb + t;
                float a[8], bq[8], h[8], so[8]; up8(hfv[r], a); up8(hbv[r], bq); up8(ov[r], so);
                float ss = 0.f;
#pragma unroll
                for (int q = 0; q < 8; ++q) { h[q] = a[q] + bq[q]; ss += h[q] * h[q]; }
                ss += __shfl_xor(ss, 1); ss += __shfl_xor(ss, 2); ss += __shfl_xor(ss, 4); ss += __shfl_xor(ss, 8);
                const float rs = 1.0f / sqrtf(ss * (1.0f / DH) + EPS);
                v4u ya; ya.x = cvtpk(h[0] * rs * gh[0].x * so[0], h[1] * rs * gh[0].y * so[1]); ya.y = cvtpk(h[2] * rs * gh[0].z * so[2], h[3] * rs * gh[0].w * so[3]);
                ya.z = cvtpk(h[4] * rs * gh[1].x * so[4], h[5] * rs * gh[1].y * so[5]); ya.w = cvtpk(h[6] * rs * gh[1].z * so[6], h[7] * rs * gh[1].w * so[7]);
                *(GAS v4u*)(F.HBUF + m * D + 8 * lane) = ya;
                const float ic = 1.0f / (float)(min(t + hw, SEQ) - max(t - hw, 0));
                float c[8], xn[8], xo[8]; up8(uc[r], c); up8(un[r], xn); up8(uo[r], xo);
                v4u yb; yb.x = cvtpk(S[0] * ic - c[0], S[1] * ic - c[1]); yb.y = cvtpk(S[2] * ic - c[2], S[3] * ic - c[3]);
                yb.z = cvtpk(S[4] * ic - c[4], S[5] * ic - c[5]); yb.w = cvtpk(S[6] * ic - c[6], S[7] * ic - c[7]);
                *(GAS v4u*)(F.HBUF + m * D + 512 + 8 * lane) = yb;
                const float kn = (t + hw < SEQ) ? 1.f : 0.f, ko = (t - hw >= 0) ? 1.f : 0.f;
#pragma unroll
                for (int q = 0; q < 8; ++q) S[q] += kn * xn[q] - ko * xo[q];
            }
        }
    }
}

__device__ __forceinline__ void p9_final(Frame& F) {
    const int lane = F.lane, NGW = F.G * NWAVES;
    f32x4 g[4];
#pragma unroll
    for (int j = 0; j < 4; ++j) g[j] = *(const GAS f32x4*)(F.g_final + 4 * lane + 256 * j);
    for (int m = F.vcu * NWAVES + F.wave; m < M; m += NGW) {
        GAS f32x4* xr = (GAS f32x4*)(F.out + (size_t)m * D) + lane;
        f32x4 v[4]; float s = 0.f;
#pragma unroll
        for (int j = 0; j < 4; ++j) { v[j] = xr[64 * j]; s += (v[j].x * v[j].x + v[j].y * v[j].y) + (v[j].z * v[j].z + v[j].w * v[j].w); }
        const float rstd = 1.0f / sqrtf(wave_sum(s) * (1.0f / D) + EPS);
#pragma unroll
        for (int j = 0; j < 4; ++j) xr[64 * j] = v[j] * rstd * g[j];
    }
}

struct Args { const float* in[16]; float* out; unsigned char* ws; int ph_lo, ph_hi, li, pad; };
__global__ void __launch_bounds__(NWAVES * 64, 2) mk_fwd(Args args) {
    extern __shared__ __attribute__((aligned(16))) unsigned char lds[];
    Frame F;
    F.lds = (LAS unsigned char*)lds;
    F.MISC = (volatile LAS unsigned*)(F.lds + MISC_OFF);
    F.tid = threadIdx.x; F.lane = F.tid & 63; F.wave = __builtin_amdgcn_readfirstlane(F.tid >> 6);
    F.G = gridDim.x; { const int bx = blockIdx.x; F.vcu = (F.G % 8 == 0) ? (bx % 8) * (F.G / 8) + bx / 8 : bx; }
#define GRID_BAR(seam) do { if (N_LAUNCHES == PER_PHASE) { if (F.tid == 0) __hip_atomic_store(F.ctl + CW_TMO, 0xBADBA0u | (unsigned)(seam), RLX_AGENT); } \
    else { xcd_barrier(bar); } } while (0)
    unsigned char* ws = args.ws;
    F.ctl = (gu32*)(ws + WS_CTL);
    F.x = args.in[0]; F.c = args.in[1]; F.w_ada = args.in[2]; F.b_ada = args.in[3]; F.g_mix = args.in[4]; F.w_in = args.in[5]; F.b_ig = args.in[6]; F.b_fg = args.in[7];
    F.g_head = args.in[8]; F.w_pool = args.in[9]; F.pool_scale = args.in[10]; F.w_out = args.in[11]; F.g_ffn = args.in[12]; F.w_ff1 = args.in[13]; F.w_ff2 = args.in[14]; F.g_final = args.in[15];
    F.out = args.out;
    F.mod = (float*)(ws + WS_MOD); F.GT = (float*)(ws + WS_GT); F.HFb = (bf16*)(ws + WS_HF); F.HBb = (bf16*)(ws + WS_HB);
    F.WIN = (bf16*)(ws + WS_WIN); F.WOUT = (bf16*)(ws + WS_WOUT); F.W1 = (bf16*)(ws + WS_W1); F.W2 = (bf16*)(ws + WS_W2);
    F.HBUF = (bf16*)(ws + WS_H); F.QB = (bf16*)(ws + WS_Q); F.KB = (bf16*)(ws + WS_K); F.VB = (bf16*)(ws + WS_V); F.OB = (bf16*)(ws + WS_O); F.UB = (bf16*)(ws + WS_U); F.AB = (bf16*)(ws + WS_A);
    for (int u = F.tid; u < (LDS_BYTES - LDSCTL_OFF) / 4; u += NWAVES * 64) ((LAS unsigned*)(F.lds + LDSCTL_OFF))[u] = 0u;
    __syncthreads();
    XcdBarrier bar; bar.bar = (unsigned*)(F.ctl + CW_BAR); bar.x = 0; bar.st = nullptr;
    if (N_LAUNCHES != PER_PHASE) bar = xcd_barrier_post((unsigned*)(F.ctl + CW_BAR), F.MISC + 8);

    const int lo = args.ph_lo, hi = args.ph_hi;
#define IN(k) (lo <= (k) && (k) < hi)
#define BOTH(k) (IN(k) && IN((k) + 1))
#ifndef PROBE_PHASE
#define PROBE_PHASE -1
#endif
#define REPS(k) ((k) == PROBE_PHASE ? 2 : 1)
    if (IN(0)) { for (int rep = 0; rep < REPS(0); ++rep) { p0_prologue(F); if (BOTH(0)) GRID_BAR(0); } }
    if (IN(1)) { for (int rep = 0; rep < REPS(1); ++rep) { rows_norm_mod<true>(F, F.x, F.g_mix, 0 * D, 1 * D, F.HBUF); if (BOTH(1)) GRID_BAR(1); } }
    if (IN(2)) { for (int rep = 0; rep < REPS(2); ++rep) {
        pg8::Gemm g{F.HBUF, F.WIN, M, NPROJ, D}; pg8::StaticOrder S; S.init(M, NPROJ, F.G, (int)blockIdx.x);
        pg8::EpiProj E{F.QB, (size_t)(WS_K - WS_Q) / 2};
        pg8::gemm_phase<pg8::EpiProj, pg8::StaticOrder, PG8_ALIGN, PG8_SP2>(F.lds + RING_OFF, g, S, E);
        if (BOTH(2)) GRID_BAR(2);
    } }
    if (IN(3)) { for (int rep = 0; rep < REPS(3); ++rep) { for (int it = F.vcu; it < 256; it += F.G) scan::scan_item(F, it); if (BOTH(3)) GRID_BAR(3); } }
    if (IN(4)) { for (int rep = 0; rep < REPS(4); ++rep) { p4_combine(F); if (BOTH(4)) GRID_BAR(4); } }
    if (IN(5)) { for (int rep = 0; rep < REPS(5); ++rep) {
        pg8::Gemm g{F.HBUF, F.WOUT, M, D, D}; pg8::StaticOrder S; S.init(M, D, F.G, (int)blockIdx.x);
        pg8::EpiRes E{F.x, F.out, F.mod + 2 * D};
        pg8::gemm_phase<pg8::EpiRes, pg8::StaticOrder, PG8_ALIGN, PG8_SP2>(F.lds + RING_OFF, g, S, E);
        if (BOTH(5)) GRID_BAR(5);
    } }
    if (IN(6)) { for (int rep = 0; rep < REPS(6); ++rep) { rows_norm_mod<false>(F, F.out, F.g_ffn, 3 * D, 4 * D, F.HBUF); if (BOTH(6)) GRID_BAR(6); } }
    if (IN(7)) { for (int rep = 0; rep < REPS(7); ++rep) {
        pg8::Gemm g{F.HBUF, F.W1, M, FF, D}; pg8::StaticOrder S; S.init(M, FF, F.G, (int)blockIdx.x);
        pg8::EpiRelu2 E{F.AB, FF};
        pg8::gemm_phase<pg8::EpiRelu2, pg8::StaticOrder, PG8_ALIGN, PG8_SP2>(F.lds + RING_OFF, g, S, E);
        if (BOTH(7)) GRID_BAR(7);
    } }
    if (IN(8)) {
        pg8::Gemm g{F.AB, F.W2, M, D, FF}; pg8::StaticOrder S; S.init(M, D, F.G, (int)blockIdx.x);
        pg8::EpiRes E{F.out, F.out, F.mod + 5 * D};
        pg8::gemm_phase<pg8::EpiRes, pg8::StaticOrder, PG8_ALIGN, PG8_SP2>(F.lds + RING_OFF, g, S, E);
        if (BOTH(8)) GRID_BAR(8);
    }
    if (IN(9)) { p9_final(F); }
#undef IN
#undef BOTH
}

extern "C" void kernel_launch(void* const* d_in, const int* in_sizes, int n_in, void* d_out, int out_size, void* d_ws, size_t ws_size, hipStream_t stream) {
    static int grid = 0;
    if (grid == 0) {
        if (n_in != 16 || in_sizes[0] != M * D || out_size != M * D || ws_size < WS_END) { fprintf(stderr, "kernel_launch: unexpected shapes (n_in %d in0 %d out %d ws %zu); nothing launched\n", n_in, n_in > 0 ? in_sizes[0] : -1, out_size, ws_size); grid = -1; return; }
        int dev = 0, cus = 0, per_cu = 0;
        if (hipGetDevice(&dev) != hipSuccess || hipDeviceGetAttribute(&cus, hipDeviceAttributeMultiprocessorCount, dev) != hipSuccess) { grid = -1; return; }
        if (hipFuncSetAttribute((const void*)mk_fwd, hipFuncAttributeMaxDynamicSharedMemorySize, LDS_BYTES) != hipSuccess) { fprintf(stderr, "kernel_launch: hipFuncSetAttribute failed\n"); grid = -1; return; }
        if (hipOccupancyMaxActiveBlocksPerMultiprocessor(&per_cu, (const void*)mk_fwd, NWAVES * 64, LDS_BYTES) != hipSuccess || per_cu < 1)
            fprintf(stderr, "kernel_launch: note: occupancy query reports %d workgroups per CU\n", per_cu);
        (void)hipGetLastError();
        grid = cus;
    }
    if (grid < 0) return;
    if (hipMemsetAsync((char*)d_ws + WS_CTL, 0, CTL_ZERO_BYTES, stream) != hipSuccess) { fprintf(stderr, "kernel_launch: hipMemsetAsync failed\n"); return; }
    Args a{};
    for (int i = 0; i < 16; ++i) a.in[i] = (const float*)d_in[i];
    a.out = (float*)d_out; a.ws = (unsigned char*)d_ws;
    for (int li = 0; li < N_LAUNCHES; ++li) {
        a.ph_lo = (N_LAUNCHES == PER_PHASE) ? li : 0; a.ph_hi = (N_LAUNCHES == PER_PHASE) ? li + 1 : PER_PHASE; a.li = li;
        hipLaunchKernelGGL(mk_fwd, dim3(grid), dim3(NWAVES * 64), LDS_BYTES, stream, a);
        const hipError_t le = hipPeekAtLastError();
        if (le != hipSuccess) { fprintf(stderr, "kernel_launch: launch %d failed: %s\n", li, hipGetErrorName(le)); break; }
    }
}
```
